# Optimizing an MI355X kernel written in HIP

```python
import math
import jax, jax.numpy as jnp
from jax import lax
import numpy as np

D_MODEL = 1024
BATCH = 2
SEQ = 8192
DEPTH = 2
DEC_BATCH = 32
DEC_SEQ = 4
PAST_LEN = 8192
PAGE_SIZE = 128

N_EVEN = (DEPTH + 1) // 2
N_ODD = DEPTH // 2
N_META = 16
ATT_HEADS = 4
QK_DIM = 64
V_DIM = 2 * QK_DIM
QW = ATT_HEADS * 2 * QK_DIM
ATT_W = ATT_HEADS * V_DIM
ROT_DIM = QK_DIM // 4
ROPE_THETA = 500000.0
Q_BLOCK = 128
S5_W = D_MODEL - ATT_W
S5_GC = 16
S5_G = S5_W // S5_GC
S5_N = 64
IN_W = 2 * QW + ATT_W + S5_W
POOL_WINDOWS = (2, 4, 8, 16)
N_POOL = len(POOL_WINDOWS)
POOL_GC = D_MODEL // N_POOL
POOL_BUF = max(POOL_WINDOWS) - 1
D_FF = 4 * D_MODEL
EPS = 1e-6
NEG = -1e30

kernel_name = 'hybrid_diffattn_s5_pool_decode_step'

f32 = jnp.float32


def _rmsnorm(x, g):
    xf = x.astype(f32)
    y = xf * lax.rsqrt(jnp.mean(xf * xf, axis=-1, keepdims=True) + EPS)
    return (y * g.astype(f32)).astype(x.dtype)


def _rope(x, pos):
    half = ROT_DIM // 2
    inv = ROPE_THETA ** (-jnp.arange(half, dtype=f32) * 2.0 / ROT_DIM)
    ang = pos.astype(f32)[:, None] * inv[None, :]
    cos = jnp.cos(ang)[None, :, None, None, :]
    sin = jnp.sin(ang)[None, :, None, None, :]
    xf = x.astype(f32)
    x1 = xf[..., :half]
    x2 = xf[..., half:ROT_DIM]
    out = jnp.concatenate([x1 * cos - x2 * sin, x2 * cos + x1 * sin, xf[..., ROT_DIM:]], axis=-1)
    return out.astype(x.dtype)


def _diff_attn_block(q, k, v, q_pos, k_pos, lam):
    s = jnp.einsum('bqhmd,bkhmd->bhmqk', q.astype(f32), k) * (QK_DIM ** -0.5)
    s = jnp.where(k_pos[None, :] <= q_pos[:, None], s, NEG)
    p = jax.nn.softmax(s, axis=-1)
    w = p[:, :, 0] - lam * p[:, :, 1]
    return jnp.einsum('bhqk,bkhe->bqhe', w, v)


def _diff_attention(q, k, v, q_pos, k_pos, lam):
    kf = k.astype(f32)
    vf = v.astype(f32)
    bsz, Lq = q.shape[0], q.shape[1]
    if Lq <= Q_BLOCK:
        return _diff_attn_block(q, kf, vf, q_pos, k_pos, lam)
    nb = -(-Lq // Q_BLOCK)
    pad = nb * Q_BLOCK - Lq
    qp = jnp.pad(q, ((0, 0), (0, pad), (0, 0), (0, 0), (0, 0)))
    pp = jnp.pad(q_pos, (0, pad), mode='edge')
    qb = qp.reshape(bsz, nb, Q_BLOCK, ATT_HEADS, 2, QK_DIM).swapaxes(0, 1)
    pb = pp.reshape(nb, Q_BLOCK)
    out = lax.map(lambda a: _diff_attn_block(a[0], kf, vf, a[1], k_pos, lam), (qb, pb))
    out = out.swapaxes(0, 1).reshape(bsz, nb * Q_BLOCK, ATT_HEADS, V_DIM)
    return out[:, :Lq]


def _scan_op(e1, e2):
    a1, b1 = e1
    a2, b2 = e2
    return a1 * a2, a2 * b1 + b2


def _s5(u, h0, lam_re, lam_im, log_dt, b_re, b_im, c_re, c_im, d):
    bsz, L, _ = u.shape
    uf = u.astype(f32).reshape(bsz, L, S5_G, S5_GC)
    lam = lax.complex(lam_re.astype(f32), lam_im.astype(f32))
    dt = jnp.exp(log_dt.astype(f32))[:, None]
    a_bar = jnp.exp(lam * dt)
    b_bar = ((a_bar - 1.0) / lam)[..., None] * lax.complex(b_re.astype(f32), b_im.astype(f32))
    c = lax.complex(c_re.astype(f32), c_im.astype(f32))
    bu = jnp.einsum('gnc,blgc->blgn', b_bar, uf.astype(jnp.complex64))
    bu = bu.at[:, 0].add(a_bar[None] * h0)
    a = jnp.broadcast_to(a_bar, bu.shape)
    _, hs = lax.associative_scan(_scan_op, (a, bu), axis=1)
    y = jnp.real(jnp.einsum('gcn,blgn->blgc', c, hs)) + d.astype(f32).reshape(S5_G, S5_GC) * uf
    return y.reshape(bsz, L, S5_W), hs[:, -1]


def _pool_mixer(h, buf, pos0, w, b, scale):
    bsz, L, _ = h.shape
    xx = jnp.concatenate([buf, h], axis=1).astype(f32)
    cs = jnp.concatenate([jnp.zeros((bsz, 1, D_MODEL), f32), jnp.cumsum(xx, axis=1)], axis=1)
    t = (pos0 + jnp.arange(L)).astype(f32)
    cur = xx[:, POOL_BUF:]
    hi = cs[:, POOL_BUF + 1:POOL_BUF + 1 + L]
    groups = []
    for gi, win in enumerate(POOL_WINDOWS):
        sl = slice(gi * POOL_GC, (gi + 1) * POOL_GC)
        lo = cs[:, POOL_BUF + 1 - win:POOL_BUF + 1 - win + L, sl]
        cnt = jnp.minimum(t + 1.0, float(win))
        groups.append((hi[..., sl] - lo) / cnt[None, :, None] - cur[..., sl])
    pooled = jnp.stack(groups, axis=2)
    z = jnp.einsum('blgc,gce->blge', pooled, w.astype(f32)).reshape(bsz, L, D_MODEL) + b.astype(f32)
    return (z * scale.astype(f32)).astype(h.dtype), xx[:, -POOL_BUF:].astype(h.dtype)


def _forward(x, pos0, past_kv, past_s5, past_pool, p):
    bsz, L, _ = x.shape
    pos = pos0 + jnp.arange(L, dtype=jnp.int32)
    new_k, new_v, new_re, new_im, new_pool = [], [], [], [], []
    for l in range(DEPTH):
        h = _rmsnorm(x, p['norm_mix'][l])
        if l % 2 == 0:
            e = l // 2
            proj = h @ p['w_in'][e]
            q, k, v, u = jnp.split(proj, [QW, 2 * QW, 2 * QW + ATT_W], axis=-1)
            q = _rope(q.reshape(bsz, L, ATT_HEADS, 2, QK_DIM), pos)
            k = _rope(k.reshape(bsz, L, ATT_HEADS, 2, QK_DIM), pos)
            v = v.reshape(bsz, L, ATT_HEADS, V_DIM)
            new_k.append(k.reshape(bsz, L, ATT_HEADS, 2 * QK_DIM))
            new_v.append(v)
            if past_kv is None:
                k_all, v_all = k, v
            else:
                cache_k, cache_v, page_table = past_kv
                kc = cache_k[e][page_table].reshape(bsz, -1, ATT_HEADS, 2, QK_DIM)
                vc = cache_v[e][page_table].reshape(bsz, -1, ATT_HEADS, V_DIM)
                k_all = jnp.concatenate([kc.astype(k.dtype), k], axis=1)
                v_all = jnp.concatenate([vc.astype(v.dtype), v], axis=1)
            k_pos = jnp.arange(k_all.shape[1], dtype=jnp.int32)
            lam_init = 0.8 - 0.6 * math.exp(-0.3 * l)
            lam = (jnp.exp(jnp.sum(p['lambda_q1'][e].astype(f32) * p['lambda_k1'][e].astype(f32)))
                   - jnp.exp(jnp.sum(p['lambda_q2'][e].astype(f32) * p['lambda_k2'][e].astype(f32))) + lam_init)
            o = _diff_attention(q, k_all, v_all, pos, k_pos, lam)
            o = _rmsnorm(o, p['subln_g'][e]) * (1.0 - lam_init)
            if past_s5 is None:
                h0 = jnp.zeros((bsz, S5_G, S5_N), jnp.complex64)
            else:
                h0 = lax.complex(past_s5[0][e].astype(f32), past_s5[1][e].astype(f32))
            ys, hT = _s5(u, h0, p['s5_lambda_re'][e], p['s5_lambda_im'][e], p['s5_log_dt'][e],
                         p['s5_b_re'][e], p['s5_b_im'][e], p['s5_c_re'][e], p['s5_c_im'][e], p['s5_d'][e])
            ys = jax.nn.gelu(ys)
            ys = ys * jax.nn.sigmoid(ys @ p['w_glu'][e].astype(f32) + p['b_glu'][e].astype(f32))
            new_re.append(jnp.real(hT))
            new_im.append(jnp.imag(hT))
            mix = jnp.concatenate([o.reshape(bsz, L, ATT_W), ys], axis=-1).astype(x.dtype) @ p['w_o'][e]
        else:
            od = l // 2
            if past_pool is None:
                buf = jnp.zeros((bsz, POOL_BUF, D_MODEL), h.dtype)
            else:
                buf = past_pool[od].astype(h.dtype)
            mix, buf_new = _pool_mixer(h, buf, pos0, p['pool_w'][od], p['pool_b'][od], p['pool_scale'][od])
            new_pool.append(buf_new)
        x = x + mix.astype(x.dtype)
        hm = _rmsnorm(x, p['norm_mlp'][l])
        r = jax.nn.relu(hm @ p['w_up'][l])
        x = x + (r * r) @ p['w_down'][l]
    y = _rmsnorm(x, p['norm_final'])
    return y, jnp.stack(new_k), jnp.stack(new_v), jnp.stack(new_re), jnp.stack(new_im), jnp.stack(new_pool)


def setup_inputs(seed: int = 0) -> dict:
    key = jax.random.key(seed)
    ks = jax.random.split(key, 40)
    n_pages = PAST_LEN // PAGE_SIZE
    n_phys = (DEC_BATCH * n_pages * 5) // 4

    def nrm(k, shape, s):
        return jax.random.normal(k, shape, f32) * s

    page_table = jax.random.permutation(ks[7], n_phys)[:DEC_BATCH * n_pages].reshape(DEC_BATCH, n_pages).astype(jnp.int32)
    return {
        'x_prompt': nrm(ks[0], (BATCH, SEQ, D_MODEL), 1.0),
        'x_sample': nrm(ks[1], (DEC_BATCH, DEC_SEQ, D_MODEL), 1.0),
        'cache_k': nrm(ks[2], (N_EVEN, n_phys, PAGE_SIZE, ATT_HEADS, 2 * QK_DIM), 1.0),
        'cache_v': nrm(ks[3], (N_EVEN, n_phys, PAGE_SIZE, ATT_HEADS, V_DIM), 1.0),
        'state_s5_re': nrm(ks[4], (N_EVEN, DEC_BATCH, S5_G, S5_N), 0.5),
        'state_s5_im': nrm(ks[5], (N_EVEN, DEC_BATCH, S5_G, S5_N), 0.5),
        'state_pool': nrm(ks[6], (N_ODD, DEC_BATCH, POOL_BUF, D_MODEL), 1.0),
        'page_table': page_table,
        'meta_tokens': nrm(ks[8], (N_META, D_MODEL), 1.0),
        'norm_mix': 1.0 + nrm(ks[9], (DEPTH, D_MODEL), 0.02),
        'norm_mlp': 1.0 + nrm(ks[10], (DEPTH, D_MODEL), 0.02),
        'norm_final': 1.0 + nrm(ks[11], (D_MODEL,), 0.02),
        'w_in': nrm(ks[12], (N_EVEN, D_MODEL, IN_W), D_MODEL ** -0.5),
        'lambda_q1': nrm(ks[13], (N_EVEN, QK_DIM), 0.1),
        'lambda_k1': nrm(ks[14], (N_EVEN, QK_DIM), 0.1),
        'lambda_q2': nrm(ks[15], (N_EVEN, QK_DIM), 0.1),
        'lambda_k2': nrm(ks[16], (N_EVEN, QK_DIM), 0.1),
        'subln_g': 1.0 + nrm(ks[17], (N_EVEN, V_DIM), 0.02),
        's5_lambda_re': -0.5 + nrm(ks[18], (N_EVEN, S5_G, S5_N), 0.01),
        's5_lambda_im': math.pi * jnp.arange(S5_N, dtype=f32) + nrm(ks[19], (N_EVEN, S5_G, S5_N), 0.01),
        's5_log_dt': jax.random.uniform(ks[20], (N_EVEN, S5_G), f32, math.log(1e-3), math.log(1e-1)),
        's5_b_re': nrm(ks[21], (N_EVEN, S5_G, S5_N, S5_GC), (2 * S5_GC) ** -0.5),
        's5_b_im': nrm(ks[22], (N_EVEN, S5_G, S5_N, S5_GC), (2 * S5_GC) ** -0.5),
        's5_c_re': nrm(ks[23], (N_EVEN, S5_G, S5_GC, S5_N), (2 * S5_N) ** -0.5),
        's5_c_im': nrm(ks[24], (N_EVEN, S5_G, S5_GC, S5_N), (2 * S5_N) ** -0.5),
        's5_d': nrm(ks[25], (N_EVEN, S5_W), 1.0),
        'w_glu': nrm(ks[26], (N_EVEN, S5_W, S5_W), S5_W ** -0.5),
        'b_glu': nrm(ks[27], (N_EVEN, S5_W), 0.01),
        'w_o': nrm(ks[28], (N_EVEN, ATT_W + S5_W, D_MODEL), (ATT_W + S5_W) ** -0.5),
        'pool_w': nrm(ks[29], (N_ODD, N_POOL, POOL_GC, POOL_GC), POOL_GC ** -0.5),
        'pool_b': nrm(ks[30], (N_ODD, D_MODEL), 0.01),
        'pool_scale': 1.0 + nrm(ks[31], (N_ODD, D_MODEL), 0.02),
        'w_up': nrm(ks[32], (DEPTH, D_MODEL, D_FF), D_MODEL ** -0.5),
        'w_down': nrm(ks[33], (DEPTH, D_FF, D_MODEL), D_FF ** -0.5),
    }


def reference(x_prompt, x_sample, cache_k, cache_v, state_s5_re, state_s5_im, state_pool, page_table,
              meta_tokens, norm_mix, norm_mlp, norm_final, w_in, lambda_q1, lambda_k1, lambda_q2, lambda_k2,
              subln_g, s5_lambda_re, s5_lambda_im, s5_log_dt, s5_b_re, s5_b_im, s5_c_re, s5_c_im, s5_d,
              w_glu, b_glu, w_o, pool_w, pool_b, pool_scale, w_up, w_down):
    p = dict(norm_mix=norm_mix, norm_mlp=norm_mlp, norm_final=norm_final, w_in=w_in,
             lambda_q1=lambda_q1, lambda_k1=lambda_k1, lambda_q2=lambda_q2, lambda_k2=lambda_k2,
             subln_g=subln_g, s5_lambda_re=s5_lambda_re, s5_lambda_im=s5_lambda_im, s5_log_dt=s5_log_dt,
             s5_b_re=s5_b_re, s5_b_im=s5_b_im, s5_c_re=s5_c_re, s5_c_im=s5_c_im, s5_d=s5_d,
             w_glu=w_glu, b_glu=b_glu, w_o=w_o, pool_w=pool_w, pool_b=pool_b, pool_scale=pool_scale,
             w_up=w_up, w_down=w_down)
    bp = x_prompt.shape[0]
    meta = jnp.broadcast_to(meta_tokens[None].astype(x_prompt.dtype), (bp, N_META, D_MODEL))
    xp = jnp.concatenate([meta, x_prompt], axis=1)
    yp, kp, vp, rep, imp, plp = _forward(xp, 0, None, None, None, p)
    yp = yp[:, N_META:]
    past_len = page_table.shape[1] * PAGE_SIZE
    ys, ksm, vsm, res, ims, pls = _forward(x_sample, past_len, (cache_k, cache_v, page_table),
                                           (state_s5_re, state_s5_im), state_pool, p)
    return (yp, ys, kp, vp, rep, imp, plp, ksm, vsm, res, ims, pls)
```

```cpp
#include <hip/hip_runtime.h>
#include <cstdio>
#include <cstdint>
#define MK_CHECK 0
#define MK_ONE_LAUNCH 1
#define MK_NDEC 96

namespace pg8 {
#define PG8_LAS __attribute__((address_space(3)))
typedef unsigned short bf16_t;
typedef short bf16x8 __attribute__((ext_vector_type(8)));
typedef float f32x4 __attribute__((ext_vector_type(4)));
typedef unsigned u32x4 __attribute__((ext_vector_type(4)));
constexpr int BM = 256, BK = 64, HALF = 128, HTB = HALF * BK * 2, STAGE_BYTES = 8 * HTB, NXCD = 8, WGM = 8;
__host__ __device__ __forceinline__ int lds_byte(int r, int c) { const int st = (r >> 4) * 2 + (c >> 5), rr = r & 15, cc = c & 31, ob = rr * 64 + cc * 2; return st * 1024 + (ob ^ (((ob >> 9) & 1) << 5)); }
__host__ __device__ __forceinline__ void stage_rc(int b, int& R, int& C) { const int st = b / 1024, sb = b % 1024, swz = sb ^ (((sb >> 9) & 1) << 5); R = (st >> 1) * 16 + swz / 64; C = (st & 1) * 32 + (swz % 64) / 2; }
__host__ __device__ __forceinline__ int perm32(int rho) { const int n = rho >> 4, i = rho & 15; return 8 * (i >> 2) + 4 * n + (i & 3); }

struct Unit { int pm, pn, pb; };
struct Gemm { const bf16_t* A; const bf16_t* Bt; int K, lda, ldb; long a_pn, a_pb, b_pb; };
struct Order {
    int nM, nN, nB, nwg, G, c;
    __device__ __forceinline__ void init(int nM_, int nN_, int nB_, int G_, int c_) { nM = nM_; nN = nN_; nB = nB_; nwg = nM * nN * nB; G = G_; c = c_; }
    __device__ __forceinline__ bool next(int i, Unit& u) const {
        const long L = (long)i * G + c; if (L >= nwg) return false;
        if (nB > 1) { const int per = nM * nN, r = (int)(L % per); u.pb = (int)(L / per); u.pm = r % nM; u.pn = r / nM; return true; }
        int wgid = (int)L; { const int q = nwg / NXCD, r = nwg % NXCD, xcd = wgid % NXCD, off = wgid / NXCD; wgid = (xcd < r ? xcd * (q + 1) : r * (q + 1) + (xcd - r) * q) + off; }
        const int nig = WGM * nN, gid = wgid / nig, fm = gid * WGM, gsz = (nM - fm) < WGM ? (nM - fm) : WGM;
        u.pm = fm + ((wgid % nig) % gsz); u.pn = (wgid % nig) / gsz; u.pb = 0; return true;
    }
};
__device__ __forceinline__ unsigned cvt_pk_bf16(float lo, float hi) { unsigned r; asm volatile("v_cvt_pk_bf16_f32 %0, %1, %2" : "=v"(r) : "v"(lo), "v"(hi)); return r; }

template <class Epi>
__device__ __forceinline__ void gemm_phase(PG8_LAS unsigned char* lds, const Gemm g, const Order& S, const Epi& E) {
    const int tid = threadIdx.x, wid = __builtin_amdgcn_readfirstlane(tid >> 6), lane = tid & 63, wr = wid >> 2, wc = wid & 3, fr = lane & 15, fq = lane >> 4;
    const int K = g.K, nt = K / BK;
    unsigned voffA[2], voffB[2];
#pragma unroll
    for (int i = 0; i < 2; ++i) { int R, C; stage_rc(tid * 16 + i * 8192, R, C); const int Rb = (R & ~31) + perm32(R & 31);
        voffA[i] = (unsigned)(R * g.lda + C) * 2u; voffB[i] = (unsigned)(Rb * g.ldb + C) * 2u; }
    const size_t kstep = (size_t)(BK * 2);
    const size_t hstepA = (size_t)HALF * g.lda * 2, hstepB = (size_t)HALF * g.ldb * 2;
    const unsigned ldsw = (unsigned)wid * 1024u;
    const int aoff = lds_byte(wr * 64 + fr, fq * 8), boff = lds_byte(wc * 32 + fr, fq * 8);
#define PG8_APTR(u) ((const char*)g.A + ((size_t)(u).pb * g.a_pb + (size_t)(u).pn * g.a_pn + (size_t)(u).pm * BM * g.lda) * 2)
#define PG8_BPTR(u) ((const char*)g.Bt + ((size_t)(u).pb * g.b_pb + (size_t)(u).pn * BM * g.ldb) * 2)
#define PG8_SA(b, h) (((b) * 2 + (h)) * HTB)
#define PG8_SB(b, h) ((4 + (b) * 2 + (h)) * HTB)
#define PG8_STAGE(bufoff, gbase, voff) do { _Pragma("unroll") for (int _i = 0; _i < 2; ++_i) \
        __builtin_amdgcn_global_load_lds((const unsigned*)((const char*)(gbase) + (voff)[_i]), (PG8_LAS unsigned*)(lds + (bufoff) + ldsw + _i * 8192), 16, 0, 0); } while (0)
#define PG8_LDA(dst, b, h) do { _Pragma("unroll") for (int m = 0; m < 4; ++m) _Pragma("unroll") for (int k = 0; k < 2; ++k) dst[m][k] = *(const PG8_LAS bf16x8*)(lds + PG8_SA(b, h) + aoff + m * 2048 + k * 1024); } while (0)
#define PG8_LDB(dst, b, h) do { _Pragma("unroll") for (int n = 0; n < 2; ++n) _Pragma("unroll") for (int k = 0; k < 2; ++k) dst[n][k] = *(const PG8_LAS bf16x8*)(lds + PG8_SB(b, h) + boff + n * 2048 + k * 1024); } while (0)
#define PG8_MMA(ai, bj, At, Bt) do { __builtin_amdgcn_s_setprio(1); _Pragma("unroll") for (int m = 0; m < 4; ++m) _Pragma("unroll") for (int n = 0; n < 2; ++n) _Pragma("unroll") for (int k = 0; k < 2; ++k) \
        acc[ai][bj][m][n] = __builtin_amdgcn_mfma_f32_16x16x32_bf16(Bt[n][k], At[m][k], acc[ai][bj][m][n], 0, 0, 0); __builtin_amdgcn_s_setprio(0); } while (0)
#define PG8_WAIT_V(n) asm volatile("s_waitcnt vmcnt(" #n ")" ::: "memory")
#define PG8_WAIT_L(n) asm volatile("s_waitcnt lgkmcnt(" #n ")" ::: "memory")
#define PG8_BAR __builtin_amdgcn_s_barrier()
#define PG8_SCHED __builtin_amdgcn_sched_barrier(0)
    Unit cur, nxt; int ui = 0;
    if (!S.next(0, cur)) return;
    f32x4 acc[2][2][4][2];
#pragma unroll
    for (int a = 0; a < 2; ++a)
#pragma unroll
        for (int b = 0; b < 2; ++b)
#pragma unroll
            for (int m = 0; m < 4; ++m)
#pragma unroll
                for (int n = 0; n < 2; ++n) acc[a][b][m][n] = (f32x4){0.f, 0.f, 0.f, 0.f};
    bf16x8 At[4][2], B0[2][2], B1[2][2];
    const char* cA = PG8_APTR(cur); const char* cB = PG8_BPTR(cur);
    PG8_STAGE(PG8_SB(0, 0), cB, voffB); PG8_STAGE(PG8_SB(0, 1), cB + hstepB, voffB); PG8_STAGE(PG8_SA(0, 0), cA, voffA); PG8_STAGE(PG8_SA(0, 1), cA + hstepA, voffA);
    if (wr == 1) PG8_BAR;
    PG8_WAIT_V(2); PG8_BAR;
    PG8_STAGE(PG8_SB(1, 0), cB + kstep, voffB); PG8_STAGE(PG8_SA(1, 0), cA + kstep, voffA); PG8_STAGE(PG8_SB(1, 1), cB + hstepB + kstep, voffB);
    PG8_WAIT_V(6); PG8_BAR;
    for (;;) {
        const bool has_next = S.next(ui + 1, nxt);
        const char* nA = has_next ? PG8_APTR(nxt) : cA; const char* nB = has_next ? PG8_BPTR(nxt) : cB;
#pragma unroll 1
        for (int t = 0; t < nt; t += 2) {
            const bool last = (t == nt - 2);
            const char* a1 = cA + (size_t)(t + 1) * kstep;
            const char* a2 = last ? nA : cA + (size_t)(t + 2) * kstep; const char* b2 = last ? nB : cB + (size_t)(t + 2) * kstep;
            const char* a3 = a2 + kstep; const char* b3 = b2 + kstep;
            PG8_LDB(B0, 0, 0); PG8_LDB(B1, 0, 1); PG8_SCHED; PG8_LDA(At, 0, 0); PG8_STAGE(PG8_SA(1, 1), a1 + hstepA, voffA);
            PG8_WAIT_V(8); PG8_WAIT_L(0); PG8_BAR; PG8_MMA(0, 0, At, B0); PG8_MMA(0, 1, At, B1); PG8_BAR; PG8_SCHED;
            PG8_LDA(At, 0, 1); PG8_STAGE(PG8_SB(0, 0), b2, voffB); PG8_STAGE(PG8_SB(0, 1), b2 + hstepB, voffB); PG8_STAGE(PG8_SA(0, 0), a2, voffA);
            PG8_WAIT_V(8); PG8_WAIT_L(0); PG8_BAR; PG8_MMA(1, 0, At, B0); PG8_MMA(1, 1, At, B1); PG8_BAR; PG8_SCHED;
            PG8_LDB(B0, 1, 0); PG8_LDB(B1, 1, 1); PG8_SCHED; PG8_LDA(At, 1, 0); PG8_STAGE(PG8_SA(0, 1), a2 + hstepA, voffA);
            PG8_WAIT_V(8); PG8_WAIT_L(0); PG8_BAR; PG8_MMA(0, 0, At, B0); PG8_MMA(0, 1, At, B1); PG8_BAR; PG8_SCHED;
            PG8_LDA(At, 1, 1); PG8_STAGE(PG8_SB(1, 0), b3, voffB); PG8_STAGE(PG8_SB(1, 1), b3 + hstepB, voffB); PG8_STAGE(PG8_SA(1, 0), a3, voffA);
            PG8_WAIT_V(8); PG8_WAIT_L(0); PG8_BAR; PG8_MMA(1, 0, At, B0); PG8_MMA(1, 1, At, B1); PG8_BAR; PG8_SCHED;
        }
        if (wr == 0) PG8_BAR;
        E(acc, cur, wr, wc, fr, fq);
        if (!has_next) break;
#pragma unroll
        for (int a = 0; a < 2; ++a)
#pragma unroll
            for (int b = 0; b < 2; ++b)
#pragma unroll
                for (int m = 0; m < 4; ++m)
#pragma unroll
                    for (int n = 0; n < 2; ++n) acc[a][b][m][n] = (f32x4){0.f, 0.f, 0.f, 0.f};
        cur = nxt; cA = nA; cB = nB; ++ui;
        if (wr == 1) PG8_BAR;
    }
    PG8_WAIT_V(0);
    PG8_BAR;
#undef PG8_APTR
#undef PG8_BPTR
#undef PG8_SA
#undef PG8_SB
#undef PG8_STAGE
#undef PG8_LDA
#undef PG8_LDB
#undef PG8_MMA
#undef PG8_WAIT_V
#undef PG8_WAIT_L
#undef PG8_BAR
#undef PG8_SCHED
}
}

#include <hip/hip_bf16.h>
namespace attn2 {
using bf16=__hip_bfloat16;
using bf16x8=__attribute__((ext_vector_type(8)))short;
using s16x4=__attribute__((ext_vector_type(4)))short;
using f32x16=__attribute__((ext_vector_type(16)))float;
using u32x4=__attribute__((ext_vector_type(4)))unsigned;
constexpr int D=64,DM=512,QROWS=8192,KROWS=8256;
constexpr int NW=8,QBLK=32,QB=QBLK*NW,KVBLK=64,NQB=QROWS/QB;
__device__ __forceinline__ int crow(int r,int hi){return (r&3)+8*(r>>2)+4*hi;}
#define SBAR() __builtin_amdgcn_sched_barrier(0)
__device__ __forceinline__ void cmask(f32x16&p0,f32x16&p1,int jb,int qrel,int hi){
  const float NEG=-INFINITY; int kb=64*jb+4*hi;
  #pragma unroll
  for(int r=0;r<16;++r){int kv=kb+(r&3)+8*(r>>2); if(kv>qrel)p0[r]=NEG; if(kv+32>qrel)p1[r]=NEG;}
}

constexpr int NSLOT=3, SLOTB=8192;
constexpr int LDS_K=0, LDS_V=NSLOT*SLOTB, LDS_WS=LDS_V+NSLOT*2*SLOTB, LDS_OST=LDS_WS+NW*64*4, LDS_BYTES=LDS_OST+NW*4096;
constexpr float C2=0.125f*1.4426950408889634f;
__device__ __forceinline__ void glds16(const void*gsrc,unsigned lds_dst){unsigned keep;
  asm volatile("s_mov_b32 %0, m0\n\ts_mov_b32 m0, %2\n\ts_nop 0\n\tglobal_load_lds_dwordx4 %1, off\n\ts_mov_b32 m0, %0":"=&s"(keep):"v"(gsrc),"s"(lds_dst):"memory");}
__device__ __forceinline__ float max3f(float a,float b,float c){float r;asm("v_max3_f32 %0, %1, %2, %3":"=v"(r):"v"(a),"v"(b),"v"(c));return r;}
__device__ __forceinline__ float max2f(float a,float b){float r;asm("v_max_f32_e32 %0, %1, %2":"=v"(r):"v"(a),"v"(b));return r;}
__device__ __forceinline__ float fadd_s(float a,float b){float r;asm("v_add_f32_e32 %0, %1, %2":"=v"(r):"v"(a),"v"(b));return r;}
__device__ __forceinline__ float fsub_s(float a,float b){float r;asm("v_sub_f32_e32 %0, %1, %2":"=v"(r):"v"(a),"v"(b));return r;}
typedef float f32x2_t __attribute__((ext_vector_type(2))); typedef __bf16 bf16x2_t __attribute__((ext_vector_type(2)));
__device__ __forceinline__ unsigned cvtpk_s(float lo,float hi){f32x2_t v={lo,hi};bf16x2_t b=__builtin_convertvector(v,bf16x2_t);return __builtin_bit_cast(unsigned,b);}
#define WAIT_BAR(N) asm volatile("s_waitcnt vmcnt(" #N ") lgkmcnt(0)\n\ts_barrier":::"memory")

__device__ __forceinline__ void qkt(f32x16&p0,f32x16&p1,const char*Kslot,const bf16x8*qr,const f32x16&negm,int r32,int hi){
  const char*kb=Kslot+hi*1024+r32*16;
  #pragma unroll
  for(int d0=0;d0<4;++d0){
    const bf16x8 b0=*reinterpret_cast<const bf16x8*>(kb+d0*2048);
    const bf16x8 b1=*reinterpret_cast<const bf16x8*>(kb+d0*2048+512);
    if(d0==0){p0=__builtin_amdgcn_mfma_f32_32x32x16_bf16(b0,qr[0],negm,0,0,0);p1=__builtin_amdgcn_mfma_f32_32x32x16_bf16(b1,qr[0],negm,0,0,0);}
    else{p0=__builtin_amdgcn_mfma_f32_32x32x16_bf16(b0,qr[d0],p0,0,0,0);p1=__builtin_amdgcn_mfma_f32_32x32x16_bf16(b1,qr[d0],p1,0,0,0);}}
}
typedef __attribute__((address_space(3))) const char* lds_cptr;
typedef short v4i16_t __attribute__((ext_vector_type(4)));
__device__ __forceinline__ void kload8(bf16x8*kf,lds_cptr kp){
  kf[0]=*(const __attribute__((address_space(3))) bf16x8*)(kp);      kf[1]=*(const __attribute__((address_space(3))) bf16x8*)(kp+512);
  kf[2]=*(const __attribute__((address_space(3))) bf16x8*)(kp+2048); kf[3]=*(const __attribute__((address_space(3))) bf16x8*)(kp+2560);
  kf[4]=*(const __attribute__((address_space(3))) bf16x8*)(kp+4096); kf[5]=*(const __attribute__((address_space(3))) bf16x8*)(kp+4608);
  kf[6]=*(const __attribute__((address_space(3))) bf16x8*)(kp+6144); kf[7]=*(const __attribute__((address_space(3))) bf16x8*)(kp+6656);
}
__device__ __forceinline__ void kload2(bf16x8*kf,lds_cptr kp,int j){ kf[2*j]=*(const __attribute__((address_space(3))) bf16x8*)(kp+j*2048); kf[2*j+1]=*(const __attribute__((address_space(3))) bf16x8*)(kp+j*2048+512); }
__device__ __forceinline__ s16x4 vtr(lds_cptr p){ return __builtin_bit_cast(s16x4,__builtin_amdgcn_ds_read_tr16_b64_v4i16((__attribute__((address_space(3))) v4i16_t*)p)); }
__device__ __forceinline__ float rowmax(const f32x16&p0,const f32x16&p1){
  float a=max3f(p0[0],p0[1],p1[0]),b=max3f(p0[2],p0[3],p1[1]);a=max3f(a,p1[2],p1[3]);
  #pragma unroll
  for(int r=4;r<16;r+=4){a=max3f(a,p0[r],p0[r+1]);b=max3f(b,p0[r+2],p0[r+3]);a=max3f(a,p1[r],p1[r+1]);b=max3f(b,p1[r+2],p1[r+3]);}
  const float m=max2f(a,b);
  auto rr=__builtin_amdgcn_permlane32_swap(__float_as_uint(m),__float_as_uint(m),false,false);
  return max2f(__uint_as_float(rr[0]),__uint_as_float(rr[1]));
}
__device__ __forceinline__ void pv(f32x16*o,int vb,bf16x8 pa0,bf16x8 pa1,bf16x8 pa2,bf16x8 pa3){
  #pragma unroll
  for(int d0=0;d0<4;++d0){s16x4 lo[4],hi[4];
    #pragma unroll
    for(int ks=0;ks<4;++ks){
      asm volatile("ds_read_b64_tr_b16 %0,%1 offset:%c2":"=&v"(lo[ks]):"v"(vb),"i"(d0*4096+ks*1024):"memory");
      asm volatile("ds_read_b64_tr_b16 %0,%1 offset:%c2":"=&v"(hi[ks]):"v"(vb),"i"(d0*4096+ks*1024+512):"memory");}
    asm volatile("s_waitcnt lgkmcnt(0)":::"memory");SBAR();
    #define PK(k) (bf16x8){lo[k][0],lo[k][1],lo[k][2],lo[k][3],hi[k][0],hi[k][1],hi[k][2],hi[k][3]}
    o[d0]=__builtin_amdgcn_mfma_f32_32x32x16_bf16(pa0,PK(0),o[d0],0,0,0);
    o[d0]=__builtin_amdgcn_mfma_f32_32x32x16_bf16(pa1,PK(1),o[d0],0,0,0);
    o[d0]=__builtin_amdgcn_mfma_f32_32x32x16_bf16(pa2,PK(2),o[d0],0,0,0);
    o[d0]=__builtin_amdgcn_mfma_f32_32x32x16_bf16(pa3,PK(3),o[d0],0,0,0);
    #undef PK
  }
}

#ifndef ATTN_STORE16
#define ATTN_STORE16(p,v) (*(u32x4*)(p)=(v))
#endif
template<int THRL> __device__ __forceinline__ void attn_unit(int b,int hq,int qb,const bf16*Q,const bf16*__restrict__ K,const bf16*__restrict__ V,bf16*O1,bf16*O2,char*shm){
  const int tid=threadIdx.x,lane=tid&63,r32=lane&31,hi=lane>>5; const int wid=__builtin_amdgcn_readfirstlane(tid>>6);
  const long rowbase=(long)b*QROWS; const int q0=qb*QB; const int head=hq>>1;
  const bf16*Qw=Q+(rowbase+q0+wid*QBLK)*DM+hq*D;
  const bf16*Kh=K+(long)b*KROWS*DM+hq*D,*Vh=V+(long)b*KROWS*DM+head*128;
  const unsigned lds0=(unsigned)(uintptr_t)shm;
  float*wsf=(float*)(shm+LDS_WS)+wid*64;
  const bf16*ksrc=Kh+(long)lane*DM+wid*8;
  const bf16*vsrc=Vh+(long)(16*(wid&3)+(lane>>2))*DM+(wid>>2)*32+(lane&3)*8;
  const unsigned kdst=lds0+LDS_K+wid*1024, vdst=lds0+LDS_V+wid*1024;
  #define DMA_K(t,slot) glds16(ksrc+(long)(t)*KVBLK*DM,(unsigned)__builtin_amdgcn_readfirstlane(kdst+(slot)))
  #define DMA_V(t,slot) do{ glds16(vsrc+(long)(t)*KVBLK*DM,(unsigned)__builtin_amdgcn_readfirstlane(vdst+2*(slot))); glds16(vsrc+64+(long)(t)*KVBLK*DM,(unsigned)__builtin_amdgcn_readfirstlane(vdst+2*(slot)+8192)); }while(0)
  const int vb0=(int)(lds0+LDS_V)+((lane>>4)&1)*32+(lane&3)*8+(4*hi+((lane&15)>>2))*64;
  const char*Kbase=shm+LDS_K; bf16x8 kf[8];
  const lds_cptr shm3=(lds_cptr)shm; const lds_cptr kp0=shm3+LDS_K+hi*1024+r32*16; const lds_cptr vp0=shm3+LDS_V+((lane>>4)&1)*32+(lane&3)*8+(4*hi+((lane&15)>>2))*64;
  const int NT=(q0+QB)/KVBLK+1;
  DMA_K(0,0);DMA_V(0,0);DMA_K(1,SLOTB);
  bf16x8 qr[4];
  #pragma unroll
  for(int d0=0;d0<4;++d0)qr[d0]=*reinterpret_cast<const bf16x8*>(&Qw[(long)r32*DM+d0*16+hi*8]);
  float mhat=0.f,l_reg=0.f;f32x16 o[4];o[0]=f32x16{};o[1]=f32x16{};o[2]=f32x16{};o[3]=f32x16{};const f32x16 negm=f32x16{};
  const int qrel=wid*QBLK+r32;
  #define CMASK(P0,P1,t) do{int jb_=(t)-(NT-4); if(jb_>=0)cmask(P0,P1,jb_,qrel,hi);}while(0)
  bool resc=false;
  #define START(P0,P1) do{ const float rm=rowmax(P0,P1); resc=false; mhat=rm; \
    _Pragma("unroll") for(int r=0;r<16;++r){P0[r]=fsub_s(P0[r],mhat);P1[r]=fsub_s(P1[r],mhat);} \
    _Pragma("unroll") for(int r=0;r<16;++r)P0[r]=__builtin_amdgcn_exp2f(P0[r]); }while(0)
  #define RESC() do{ if(resc){ asm volatile("s_waitcnt lgkmcnt(0)":::"memory"); \
      _Pragma("unroll") for(int d_=0;d_<4;++d_) _Pragma("unroll") for(int r=0;r<16;++r)o[d_][r]*=wsf[crow(r,hi)]; } }while(0)
  f32x16 pA0,pA1,pB0,pB1;
  int sl_prev=0,sl_cur=0,sl_next=SLOTB;
  #define ROT() do{sl_prev=sl_cur;sl_cur=sl_next;sl_next=(sl_next==(NSLOT-1)*SLOTB)?0:sl_next+SLOTB;}while(0)
  DMA_K(2,2*SLOTB);
  WAIT_BAR(3);
  qkt(pA0,pA1,Kbase,qr,negm,r32,hi);asm volatile("s_nop 15\n\ts_nop 7":"+v"(pA0),"+v"(pA1));
  { const float NEGI=-INFINITY; _Pragma("unroll") for(int r=0;r<16;++r)pA0[r]=NEGI; _Pragma("unroll") for(int r=0;r<8;++r)pA1[r]=NEGI; }
  START(pA0,pA1);
  _Pragma("unroll") for(int r=0;r<16;++r)pA1[r]=__builtin_amdgcn_exp2f(pA1[r]);
  WAIT_BAR(0);
  DMA_K(3,0);DMA_V(1,SLOTB);
  ROT();
  kload8(kf,kp0+sl_cur);
  WAIT_BAR(3);
  s16x4 vlo[4],vhi[4]; u32x4 pw0,pw1,pw2,pw3;
  #define PKW(P,B) cvtpk_s(P[B],P[B+1])
  #define PAF(k) __builtin_bit_cast(bf16x8,pw##k)
  #define VFR(j) (bf16x8){vlo[(j)&3][0],vlo[(j)&3][1],vlo[(j)&3][2],vlo[(j)&3][3],vhi[(j)&3][0],vhi[(j)&3][1],vhi[(j)&3][2],vhi[(j)&3][3]}
  #define PIN(x) asm volatile("":"+v"(x))
  #define MX3(a,b,c) __builtin_fmaxf(__builtin_fmaxf((a),(b)),(c))
  #define GAPA(MF,A0,A1,A2,A3,W0,W1,PW) do{ MF; sacc+=A0; sacc+=A1; sacc+=A2; sacc+=A3; PIN(sacc); W0; W1; PIN(PW); SBAR(); }while(0)
  #define EX(v) __builtin_amdgcn_exp2f(v)
  #define GAPB(MF,X,B) do{ MF; X[B]=EX(X[B]-mhat); X[B+1]=EX(X[B+1]-mhat); PIN(X); SBAR(); }while(0)
  #define VOFF(j) (((j)<8?((j)&1):2+((j)&1))*4096+(((j)&7)>>1)*1024)
  #define VRD(j) do{ vlo[(j)&3]=vtr(vp_+VOFF(j)); vhi[(j)&3]=vtr(vp_+VOFF(j)+512); }while(0)
  #define KRD(G,j) do{ if(G){ kload2(kf,kp0+sl_next,j); SBAR(); } }while(0)
  #define STEP(C0,C1,P0,P1,t,GK,GV,GL) do{ SBAR(); \
    const lds_cptr vp_=vp0+2*sl_prev; \
    VRD(0); SBAR(); float sacc=(P0[0]+P0[1]); \
    GAPA(C0=__builtin_amdgcn_mfma_f32_32x32x16_bf16(kf[0],qr[0],negm,0,0,0), P0[2],P0[3],P0[4],P0[5],     pw0[0]=PKW(P0,0), pw0[1]=PKW(P0,2), pw0); \
    VRD(1); SBAR(); GAPA(C1=__builtin_amdgcn_mfma_f32_32x32x16_bf16(kf[1],qr[0],negm,0,0,0), P0[6],P0[7],P0[8],P0[9],     pw0[2]=PKW(P0,4), pw0[3]=PKW(P0,6), pw0); \
    VRD(2); SBAR(); GAPA(C0=__builtin_amdgcn_mfma_f32_32x32x16_bf16(kf[2],qr[1],C0,0,0,0),   P0[10],P0[11],P0[12],P0[13], pw1[0]=PKW(P0,8), pw1[1]=PKW(P0,10), pw1); \
    VRD(3); SBAR(); GAPA(C1=__builtin_amdgcn_mfma_f32_32x32x16_bf16(kf[3],qr[1],C1,0,0,0),   P0[14],P0[15],P1[0],P1[1],   pw1[2]=PKW(P0,12),pw1[3]=PKW(P0,14), pw1); \
    GAPA(C0=__builtin_amdgcn_mfma_f32_32x32x16_bf16(kf[4],qr[2],C0,0,0,0),   P1[2],P1[3],P1[4],P1[5],     pw2[0]=PKW(P1,0), pw2[1]=PKW(P1,2), pw2); \
    GAPA(C1=__builtin_amdgcn_mfma_f32_32x32x16_bf16(kf[5],qr[2],C1,0,0,0),   P1[6],P1[7],P1[8],P1[9],     pw2[2]=PKW(P1,4), pw2[3]=PKW(P1,6), pw2); \
    GAPA(C0=__builtin_amdgcn_mfma_f32_32x32x16_bf16(kf[6],qr[3],C0,0,0,0),   P1[10],P1[11],P1[12],P1[13], pw3[0]=PKW(P1,8), pw3[1]=PKW(P1,10), pw3); \
    GAPA(C1=__builtin_amdgcn_mfma_f32_32x32x16_bf16(kf[7],qr[3],C1,0,0,0),   P1[14],P1[15],0.f,0.f,       pw3[2]=PKW(P1,12),pw3[3]=PKW(P1,14), pw3); \
    l_reg+=sacc; \
    if(GK){DMA_K((t)+3,sl_cur);} if(GV){DMA_V((t)+1,sl_next);} \
    CMASK(C0,C1,t); \
    { float a=MX3(C0[0],C0[1],C1[0]),b=MX3(C0[2],C0[3],C1[1]); a=MX3(a,C1[2],C1[3]); \
      _Pragma("unroll") for(int r=4;r<16;r+=4){a=MX3(a,C0[r],C0[r+1]);b=MX3(b,C0[r+2],C0[r+3]);a=MX3(a,C1[r],C1[r+1]);b=MX3(b,C1[r+2],C1[r+3]);} \
      float rm=__builtin_fmaxf(a,b); { auto rr=__builtin_amdgcn_permlane32_swap(__float_as_uint(rm),__float_as_uint(rm),false,false); rm=__builtin_fmaxf(__uint_as_float(rr[0]),__uint_as_float(rr[1])); } \
      rm-=mhat; resc=false; \
      if(__builtin_expect(__any(rm>(float)THRL),0)){ const float dl=__builtin_fmaxf(rm,0.f); mhat+=dl; \
        const float f=__builtin_amdgcn_exp2f(-dl); l_reg*=f; if(hi==0)wsf[r32]=f; resc=true; } } \
    SBAR(); \
    GAPB(o[0]=__builtin_amdgcn_mfma_f32_32x32x16_bf16(PAF(0),VFR(0),o[0],0,0,0), C0,0);  VRD(4); SBAR(); \
    GAPB(o[1]=__builtin_amdgcn_mfma_f32_32x32x16_bf16(PAF(0),VFR(1),o[1],0,0,0), C0,2);  VRD(5); SBAR(); \
    GAPB(o[0]=__builtin_amdgcn_mfma_f32_32x32x16_bf16(PAF(1),VFR(2),o[0],0,0,0), C0,4);  VRD(6); SBAR(); \
    GAPB(o[1]=__builtin_amdgcn_mfma_f32_32x32x16_bf16(PAF(1),VFR(3),o[1],0,0,0), C0,6);  VRD(7); SBAR(); \
    GAPB(o[0]=__builtin_amdgcn_mfma_f32_32x32x16_bf16(PAF(2),VFR(4),o[0],0,0,0), C0,8);  VRD(8); SBAR(); \
    GAPB(o[1]=__builtin_amdgcn_mfma_f32_32x32x16_bf16(PAF(2),VFR(5),o[1],0,0,0), C0,10); VRD(9); SBAR(); \
    GAPB(o[0]=__builtin_amdgcn_mfma_f32_32x32x16_bf16(PAF(3),VFR(6),o[0],0,0,0), C0,12); VRD(10); SBAR(); \
    GAPB(o[1]=__builtin_amdgcn_mfma_f32_32x32x16_bf16(PAF(3),VFR(7),o[1],0,0,0), C0,14); VRD(11); SBAR(); \
    GAPB(o[2]=__builtin_amdgcn_mfma_f32_32x32x16_bf16(PAF(0),VFR(8),o[2],0,0,0), C1,0);  VRD(12); SBAR(); \
    GAPB(o[3]=__builtin_amdgcn_mfma_f32_32x32x16_bf16(PAF(0),VFR(9),o[3],0,0,0), C1,2);  VRD(13); SBAR(); \
    GAPB(o[2]=__builtin_amdgcn_mfma_f32_32x32x16_bf16(PAF(1),VFR(10),o[2],0,0,0), C1,4); VRD(14); SBAR(); \
    GAPB(o[3]=__builtin_amdgcn_mfma_f32_32x32x16_bf16(PAF(1),VFR(11),o[3],0,0,0), C1,6); VRD(15); SBAR(); \
    KRD(GL,0); GAPB(o[2]=__builtin_amdgcn_mfma_f32_32x32x16_bf16(PAF(2),VFR(12),o[2],0,0,0), C1,8); \
    KRD(GL,1); GAPB(o[3]=__builtin_amdgcn_mfma_f32_32x32x16_bf16(PAF(2),VFR(13),o[3],0,0,0), C1,10); \
    KRD(GL,2); GAPB(o[2]=__builtin_amdgcn_mfma_f32_32x32x16_bf16(PAF(3),VFR(14),o[2],0,0,0), C1,12); \
    KRD(GL,3); GAPB(o[3]=__builtin_amdgcn_mfma_f32_32x32x16_bf16(PAF(3),VFR(15),o[3],0,0,0), C1,14); \
    }while(0)
  int t=1;
  #undef CMASK
  #define CMASK(P0,P1,t) do{}while(0)
  for(;t+5<NT;t+=2){
    STEP(pB0,pB1,pA0,pA1,t,true,true,true);     WAIT_BAR(3); RESC(); ROT();
    STEP(pA0,pA1,pB0,pB1,t+1,true,true,true);   WAIT_BAR(3); RESC(); ROT();
  }
  #undef CMASK
  #define CMASK(P0,P1,t) do{int jb_=(t)-(NT-4); if(jb_>=0)cmask(P0,P1,jb_,qrel,hi);}while(0)
  #define ENDW(tt) do{ if((tt)+3<NT){WAIT_BAR(3);} else if((tt)+2<NT){WAIT_BAR(2);} else {WAIT_BAR(0);} }while(0)
  for(;t+1<NT;t+=2){
    STEP(pB0,pB1,pA0,pA1,t,(t+3<NT),(t+1<NT),(t+1<NT));       ENDW(t);   RESC(); ROT();
    STEP(pA0,pA1,pB0,pB1,t+1,(t+4<NT),(t+2<NT),(t+2<NT));     ENDW(t+1); RESC(); ROT();
  }
  { float sacc=pA0[0]+pA0[1]; _Pragma("unroll") for(int r=2;r<16;++r)sacc+=pA0[r]; _Pragma("unroll") for(int r=0;r<16;++r)sacc+=pA1[r]; l_reg+=sacc;
    pw0=(u32x4){PKW(pA0,0),PKW(pA0,2),PKW(pA0,4),PKW(pA0,6)};pw1=(u32x4){PKW(pA0,8),PKW(pA0,10),PKW(pA0,12),PKW(pA0,14)};pw2=(u32x4){PKW(pA1,0),PKW(pA1,2),PKW(pA1,4),PKW(pA1,6)};pw3=(u32x4){PKW(pA1,8),PKW(pA1,10),PKW(pA1,12),PKW(pA1,14)};
    SBAR(); pv(o,vb0+2*sl_prev,PAF(0),PAF(1),PAF(2),PAF(3)); }
  #undef PKW
  #undef PAF
  #undef VFR
  #undef PIN
  #undef MX3
  #undef GAPA
  #undef GAPB
  #undef EX
  #undef VRD
  #undef VOFF
  #undef KRD
  #undef STEP
  #undef ENDW
  {auto rr=__builtin_amdgcn_permlane32_swap(__float_as_uint(l_reg),__float_as_uint(l_reg),false,false);l_reg=__uint_as_float(rr[0])+__uint_as_float(rr[1]);}
  if(hi==0)wsf[32+r32]=l_reg;asm volatile("s_waitcnt lgkmcnt(0)":::"memory");
  float rli[16];
  #pragma unroll
  for(int r=0;r<16;++r)rli[r]=__builtin_amdgcn_rcpf(wsf[32+crow(r,hi)]);
  bf16*Ow=((hq&1)?O2:O1)+(rowbase+q0+wid*QBLK)*DM+head*128;
  { bf16*stg=(bf16*)(shm+LDS_OST)+wid*2048;
    #pragma unroll
    for(int half=0;half<2;++half){
      #pragma unroll
      for(int r=0;r<16;++r){const int orow=crow(r,hi);
        #pragma unroll
        for(int d0=0;d0<2;++d0)stg[orow*64+d0*32+r32]=__float2bfloat16(o[2*half+d0][r]*rli[r]);}
      asm volatile("s_waitcnt lgkmcnt(0)":::"memory");
      #pragma unroll
      for(int i=0;i<4;++i){const int row=i*8+(lane>>3),ch=lane&7; const u32x4 v=*(const u32x4*)(stg+row*64+ch*8); ATTN_STORE16(Ow+(long)row*DM+half*64+ch*8,v);}
      asm volatile("s_waitcnt lgkmcnt(0)":::"memory"); } }
  asm volatile("s_waitcnt lgkmcnt(0)\n\ts_barrier":::"memory");
  #undef DMA_K
  #undef DMA_V
  #undef CMASK
  #undef START
  #undef RESC
  #undef ROT
}
constexpr int ATTN_LDS_BYTES=LDS_BYTES;
#undef SBAR
#undef WAIT_BAR
}

namespace mk {
using pg8::bf16_t; using pg8::f32x4; using pg8::u32x4; using pg8::Unit; using pg8::cvt_pk_bf16;
#define GAS __attribute__((address_space(1)))
#define LAS __attribute__((address_space(3)))
typedef short bf16x8 __attribute__((ext_vector_type(8)));
typedef float f32x2 __attribute__((ext_vector_type(2)));
typedef unsigned u32x2 __attribute__((ext_vector_type(2)));
constexpr int NWAVES = 8, NTHR = 512;
constexpr int NMAIN = 16384, XR0 = 16384, NMETA = 16, NSAMP = 128, RVALID = 16528, RG = 16640, NTILE = 64, SEQ = 8192, LP = 8208, KROWS = 8256, SB = 32, NPAGES = 64, DFF = 4096;
constexpr float EPS = 1e-6f, C2 = 0.125f * 1.4426950408889634f;
constexpr size_t O_YP = 0, O_YS = O_YP + (size_t)NMAIN * 1024, O_KP = O_YS + (size_t)NSAMP * 1024, O_VP = O_KP + (size_t)2 * LP * 512, O_RP = O_VP + (size_t)2 * LP * 512, O_IP = O_RP + 4096,
                 O_PP = O_IP + 4096, O_KS = O_PP + (size_t)2 * 15 * 1024, O_VS = O_KS + (size_t)NSAMP * 512, O_RS = O_VS + (size_t)NSAMP * 512, O_IS = O_RS + (size_t)SB * 2048,
                 O_PS = O_IS + (size_t)SB * 2048, O_END = O_PS + (size_t)SB * 15 * 1024;
constexpr size_t MiB = 1u << 20;
constexpr size_t WS_CTL = 0, CTL_ZERO_BYTES = 512 * 1024;
constexpr size_t WS_WIN = 2 * MiB, WS_WGLU = 6 * MiB, WS_WO = 7 * MiB, WS_POOLT = 9 * MiB, WS_WUP0 = 10 * MiB, WS_WDN0 = 18 * MiB, WS_WUP1 = 26 * MiB, WS_WDN1 = 34 * MiB;
constexpr size_t WS_S5A = 42 * MiB, WS_S5C = 46 * MiB, WS_ROPE = 52 * MiB, WS_SMETA = 53 * MiB, WS_UX = 53 * MiB + 512 * 1024, WS_XB = 54 * MiB, WS_QB = 87 * MiB, WS_KB = 104 * MiB, WS_VB = 121 * MiB;
constexpr size_t WS_A2 = 138 * MiB, WS_S5S = 162 * MiB, WS_YS = 178 * MiB, WS_O1 = 195 * MiB, WS_O2 = 212 * MiB, WS_DPART = 229 * MiB, WS_CAT = 238 * MiB, WS_X1 = 271 * MiB, WS_HB = 337 * MiB, WS_PA = 467 * MiB, WS_END = 500 * MiB;
constexpr int NDPG = 8, NDIT = 64 / NDPG, NDCH = 2 * NDIT;
constexpr int CW_TMO = 0, CW_BAR = 4096, CW_QUEUE = 8192, CW_ROWSQ = 16384;
constexpr int CW_FIN = 100352, CW_FINX = CW_FIN + 64 * 64;
constexpr int RING_OFF = 0, RING_BYTES = 131072, LDSCTL_OFF = RING_BYTES, MISC_OFF = LDSCTL_OFF + 320, LDS_BYTES = 147456;

#define RLX_AGENT __ATOMIC_RELAXED, __HIP_MEMORY_SCOPE_AGENT
__device__ __forceinline__ unsigned f2bf(float f) { unsigned u = __builtin_bit_cast(unsigned, f); return (u + 0x7fffu + ((u >> 16) & 1u)) >> 16; }
__device__ __forceinline__ unsigned pk2(float lo, float hi) { return f2bf(lo) | (f2bf(hi) << 16); }
__device__ __forceinline__ float bf2f(unsigned short b) { return __builtin_bit_cast(float, (unsigned)b << 16); }
__device__ __forceinline__ float bflo(unsigned w) { return __builtin_bit_cast(float, w << 16); }
__device__ __forceinline__ float bfhi(unsigned w) { return __builtin_bit_cast(float, w & 0xffff0000u); }

#define XB_TMO      128
#define XB_XCNT(j)  (256  + 64 * (j))
#define XB_XSUB(j)  (1280 + 64 * (j))
#define XB_XGEN(j)  (2304 + 64 * (j))
#define XB_TOP      3328
#define XB_TOPGEN   3392
#define XCD_BAR_WORDS 3456
#define XB_SPIN_CAP (1u << 18)
__device__ __forceinline__ unsigned xb_ld(unsigned* p)              { return __hip_atomic_load(p, __ATOMIC_RELAXED, __HIP_MEMORY_SCOPE_AGENT); }
__device__ __forceinline__ unsigned xb_add(unsigned* p, unsigned v) { return __hip_atomic_fetch_add(p, v, __ATOMIC_RELAXED, __HIP_MEMORY_SCOPE_AGENT); }
__device__ __forceinline__ unsigned xb_xcc_id() { return (unsigned)__builtin_amdgcn_s_getreg((3 << 11) | 20) & 0xFu; }
#define XB_SPIN(cond, bar) do { unsigned _sp = 0; while (cond) { __builtin_amdgcn_s_sleep(1); \
    if ((++_sp & 255u) == 0u) { if (xb_ld(&(bar)[XB_TMO])) break; if (_sp > XB_SPIN_CAP) { atomicAdd(&(bar)[XB_TMO], 1u); break; } } } } while (0)
struct XcdBarrier { unsigned* bar; unsigned x; volatile LAS unsigned* st; };
__device__ __forceinline__ XcdBarrier xcd_barrier_post(unsigned* bar, volatile LAS unsigned* st) {
    XcdBarrier b; b.bar = bar; b.x = xb_xcc_id(); b.st = st;
    if (threadIdx.x == 0) (void)xb_add(&bar[XB_XCNT(b.x)], 1u);
    return b;
}
__device__ __forceinline__ void xcd_barrier_complete(unsigned* bar, unsigned x, unsigned& nloc, unsigned& nx) {
    const unsigned G = gridDim.x * gridDim.y * gridDim.z;
    unsigned sum, cnt, mine, sp = 0u;
    for (;;) {
        sum = 0u; cnt = 0u; mine = 0u;
#pragma unroll
        for (unsigned j = 0; j < 16; ++j) { const unsigned c = xb_ld(&bar[XB_XCNT(j)]); sum += c; cnt += (c > 0u) ? 1u : 0u; mine = (j == x) ? c : mine; }
        if (sum == G) break;
        __builtin_amdgcn_s_sleep(1);
        if ((++sp & 255u) == 0u) { if (xb_ld(&bar[XB_TMO])) break; if (sp > XB_SPIN_CAP) { atomicAdd(&bar[XB_TMO], 1u); break; } }
    }
    nloc = mine > 0u ? mine : 1u; nx = cnt > 0u ? cnt : 1u;
}
__device__ __forceinline__ void xcd_barrier(const XcdBarrier& b) {
    asm volatile("s_waitcnt vmcnt(0)" ::: "memory");
    __syncthreads();
    if (threadIdx.x == 0) {
        unsigned* bar = b.bar;
        __builtin_amdgcn_s_waitcnt(0);
        unsigned nloc = b.st[0], nx = b.st[1];
        if (nloc == 0u) { xcd_barrier_complete(bar, b.x, nloc, nx); b.st[0] = nloc; b.st[1] = nx; }
        const unsigned old = xb_add(&bar[XB_XSUB(b.x)], 1u);
        const unsigned gen = old / nloc;
        if (old + 1u == (gen + 1u) * nloc) {
            __builtin_amdgcn_fence(__ATOMIC_RELEASE, "agent");
            asm volatile("s_waitcnt vmcnt(0)" ::: "memory");
            const unsigned og = xb_add(&bar[XB_TOP], 1u);
            const unsigned tg = og / nx;
            if (og + 1u == (tg + 1u) * nx) xb_add(&bar[XB_TOPGEN], 1u);
            else XB_SPIN(xb_ld(&bar[XB_TOPGEN]) == tg, bar);
            __builtin_amdgcn_fence(__ATOMIC_ACQUIRE, "agent");
            xb_add(&bar[XB_XGEN(b.x)], 1u);
            asm volatile("s_waitcnt vmcnt(0)" ::: "memory");
        } else {
            XB_SPIN(xb_ld(&bar[XB_XGEN(b.x)]) == gen, bar);
            __builtin_amdgcn_fence(__ATOMIC_ACQUIRE, "agent");
            asm volatile("s_waitcnt vmcnt(0)" ::: "memory");
        }
    }
    __syncthreads();
}

struct Args { const float* in[34]; float* out; unsigned char* ws; int ph_lo, ph_hi; };
struct Ctx {
    const float *x_prompt, *x_sample, *cache_k, *cache_v, *st_re, *st_im, *st_pool; const int* page_table;
    const float *meta, *norm_mix, *norm_mlp, *norm_final, *w_in, *lq1, *lk1, *lq2, *lk2, *subln, *lam_re, *lam_im, *log_dt, *b_re, *b_im, *c_re, *c_im, *s5d, *w_glu, *b_glu, *w_o, *pool_w, *pool_b, *pool_scale, *w_up, *w_down;
    float* out; unsigned char* ws; unsigned* ctl; float* rowsq;
    bf16_t *WIN, *WGLU, *WO, *POOLT, *WUP0, *WDN0, *WUP1, *WDN1, *S5A, *S5C, *XB, *XB2, *QB, *KB, *VB, *A2, *YS, *O1, *O2, *CAT, *HB, *PA;
    float *ROPE, *SMETA, *UX, *S5S, *DPART, *X1;
    LAS unsigned char* lds; volatile LAS unsigned* MISC;
    int tid, lane, wave, G, bid;
};
__device__ __forceinline__ void ctx_init(Ctx& C, const Args& a, LAS unsigned char* lds) {
    C.x_prompt = a.in[0]; C.x_sample = a.in[1]; C.cache_k = a.in[2]; C.cache_v = a.in[3]; C.st_re = a.in[4]; C.st_im = a.in[5]; C.st_pool = a.in[6]; C.page_table = (const int*)a.in[7];
    C.meta = a.in[8]; C.norm_mix = a.in[9]; C.norm_mlp = a.in[10]; C.norm_final = a.in[11]; C.w_in = a.in[12]; C.lq1 = a.in[13]; C.lk1 = a.in[14]; C.lq2 = a.in[15]; C.lk2 = a.in[16];
    C.subln = a.in[17]; C.lam_re = a.in[18]; C.lam_im = a.in[19]; C.log_dt = a.in[20]; C.b_re = a.in[21]; C.b_im = a.in[22]; C.c_re = a.in[23]; C.c_im = a.in[24]; C.s5d = a.in[25];
    C.w_glu = a.in[26]; C.b_glu = a.in[27]; C.w_o = a.in[28]; C.pool_w = a.in[29]; C.pool_b = a.in[30]; C.pool_scale = a.in[31]; C.w_up = a.in[32]; C.w_down = a.in[33];
    C.out = a.out; C.ws = a.ws; C.ctl = (unsigned*)(a.ws + WS_CTL); C.rowsq = (float*)(C.ctl + CW_ROWSQ);
    C.WIN = (bf16_t*)(a.ws + WS_WIN); C.WGLU = (bf16_t*)(a.ws + WS_WGLU); C.WO = (bf16_t*)(a.ws + WS_WO); C.POOLT = (bf16_t*)(a.ws + WS_POOLT);
    C.WUP0 = (bf16_t*)(a.ws + WS_WUP0); C.WDN0 = (bf16_t*)(a.ws + WS_WDN0); C.WUP1 = (bf16_t*)(a.ws + WS_WUP1); C.WDN1 = (bf16_t*)(a.ws + WS_WDN1);
    C.S5A = (bf16_t*)(a.ws + WS_S5A); C.S5C = (bf16_t*)(a.ws + WS_S5C); C.XB = (bf16_t*)(a.ws + WS_XB); C.XB2 = (bf16_t*)(a.ws + WS_X1); C.QB = (bf16_t*)(a.ws + WS_QB); C.KB = (bf16_t*)(a.ws + WS_KB); C.VB = (bf16_t*)(a.ws + WS_VB);
    C.A2 = (bf16_t*)(a.ws + WS_A2); C.YS = (bf16_t*)(a.ws + WS_YS); C.O1 = (bf16_t*)(a.ws + WS_O1); C.O2 = (bf16_t*)(a.ws + WS_O2); C.CAT = (bf16_t*)(a.ws + WS_CAT); C.HB = (bf16_t*)(a.ws + WS_HB); C.PA = (bf16_t*)(a.ws + WS_PA);
    C.ROPE = (float*)(a.ws + WS_ROPE); C.SMETA = (float*)(a.ws + WS_SMETA); C.UX = (float*)(a.ws + WS_UX); C.S5S = (float*)(a.ws + WS_S5S); C.DPART = (float*)(a.ws + WS_DPART); C.X1 = (float*)(a.ws + WS_X1);
    C.lds = lds; C.MISC = (volatile LAS unsigned*)(lds + MISC_OFF);
    C.tid = threadIdx.x; C.lane = C.tid & 63; C.wave = __builtin_amdgcn_readfirstlane(C.tid >> 6); C.G = gridDim.x; C.bid = blockIdx.x;
}
__device__ __forceinline__ float wave_sum(float v) {
#pragma unroll
    for (int o = 1; o < 64; o <<= 1) v += __shfl_xor(v, o);
    return v;
}
__device__ __forceinline__ const float* xin_row(const Ctx& C, int r) {
    if (r < NMAIN) return C.x_prompt + (size_t)r * 1024;
    if (r < XR0 + NMETA) return C.meta + (size_t)(r - XR0) * 1024;
    if (r < RVALID) return C.x_sample + (size_t)(r - XR0 - NMETA) * 1024;
    return nullptr;
}
__device__ __forceinline__ int row_pos(int r) { return r < NMAIN ? NMETA + (r & (SEQ - 1)) : (r < XR0 + NMETA ? r - XR0 : SEQ + ((r - XR0 - NMETA) & 3)); }
__device__ __forceinline__ float lam_full(const Ctx& C) {
    const float s1 = wave_sum(C.lq1[C.lane] * C.lk1[C.lane]), s2 = wave_sum(C.lq2[C.lane] * C.lk2[C.lane]);
    return expf(s1) - expf(s2) + 0.2f;
}

__device__ __forceinline__ void p0_transpose_item(const float* W, int ldw, int N, bf16_t* WT, int ldt, int row_off, const float* g, LAS float* scr, int item, int lane) {
    const int nblk = N / 32, kb = item / nblk, nb = item % nblk, k0 = 64 * kb, n0 = 32 * nb;
    float wv[32];
#pragma unroll
    for (int i = 0; i < 32; ++i) wv[i] = W[(size_t)(k0 + 2 * i + (lane >> 5)) * ldw + n0 + (lane & 31)];
#pragma unroll
    for (int i = 0; i < 32; ++i) { const int kk = 2 * i + (lane >> 5); float v = wv[i]; if (g) v *= g[k0 + kk]; scr[kk * 33 + (lane & 31)] = v; }
    asm volatile("s_waitcnt lgkmcnt(0)" ::: "memory");
    const int c = lane & 7;
#pragma unroll
    for (int j = 0; j < 4; ++j) { const int n = (lane >> 3) + 8 * j; const LAS float* s = scr + (8 * c) * 33 + n;
        u32x4 o; o.x = pk2(s[0 * 33], s[1 * 33]); o.y = pk2(s[2 * 33], s[3 * 33]); o.z = pk2(s[4 * 33], s[5 * 33]); o.w = pk2(s[6 * 33], s[7 * 33]);
        *(u32x4*)(WT + (size_t)(row_off + n0 + n) * ldt + k0 + 8 * c) = o; }
    asm volatile("s_waitcnt lgkmcnt(0)" ::: "memory");
}
__device__ __forceinline__ void p0_row(const Ctx& C, int r) {
    const float* src = xin_row(C, r); u32x2* o8 = (u32x2*)(C.XB + (size_t)r * 1024) + C.lane;
    if (!src) { for (int j = 0; j < 4; ++j) o8[64 * j] = (u32x2){0u, 0u}; if (C.lane == 0) C.rowsq[r] = 0.f; return; }
    const f32x4* xr = (const f32x4*)src + C.lane; float s = 0.f;
#pragma unroll
    for (int j = 0; j < 4; ++j) { const f32x4 v = xr[64 * j]; s += (v.x * v.x + v.y * v.y) + (v.z * v.z + v.w * v.w); o8[64 * j] = (u32x2){pk2(v.x, v.y), pk2(v.z, v.w)}; }
    s = wave_sum(s); if (C.lane == 0) C.rowsq[r] = s;
}
__device__ __forceinline__ void p0_rows4(const Ctx& C, int r, int stride) {
    f32x4 v[4][4]; bool have[4];
#pragma unroll
    for (int q = 0; q < 4; ++q) { const int row = r + q * stride; const float* src = row < RG ? xin_row(C, row) : nullptr; have[q] = src != nullptr;
#pragma unroll
        for (int j = 0; j < 4; ++j) v[q][j] = have[q] ? *((const f32x4*)src + 64 * j + C.lane) : (f32x4){0.f, 0.f, 0.f, 0.f}; }
#pragma unroll
    for (int q = 0; q < 4; ++q) { const int row = r + q * stride; if (row >= RG) continue; u32x2* o8 = (u32x2*)(C.XB + (size_t)row * 1024) + C.lane; float s = 0.f;
#pragma unroll
        for (int j = 0; j < 4; ++j) { const f32x4 x = v[q][j]; s += (x.x * x.x + x.y * x.y) + (x.z * x.z + x.w * x.w); o8[64 * j] = (u32x2){pk2(x.x, x.y), pk2(x.z, x.w)}; }
        s = wave_sum(s); if (C.lane == 0) C.rowsq[row] = s; }
}
__device__ __forceinline__ void p0_s5_group(const Ctx& C, int g, int sub) {
    LAS float* AP = (LAS float*)C.lds;
    LAS float* BB = AP + 17 * 64 * 2;
    LAS float* CC = BB + 64 * 16 * 2;
    LAS float* KT = CC + 16 * 64 * 2;
    const float dt = expf(C.log_dt[g]);
    for (int t = C.tid; t < 17 * 64; t += NTHR) { const int n = t & 63, lag = t >> 6; const float lr = C.lam_re[g * 64 + n], li = C.lam_im[g * 64 + n];
        const float mag = expf((float)lag * dt * lr), ang = (float)lag * dt * li; float sn, cs; sincosf(ang, &sn, &cs); AP[t * 2] = mag * cs; AP[t * 2 + 1] = mag * sn; }
    for (int t = C.tid; t < 1024; t += NTHR) { const int n = t >> 4; const float lr = C.lam_re[g * 64 + n], li = C.lam_im[g * 64 + n];
        const float mag = expf(dt * lr); float sn, cs; sincosf(dt * li, &sn, &cs); const float nr = mag * cs - 1.0f, ni = mag * sn, den = lr * lr + li * li;
        const float fre = (nr * lr + ni * li) / den, fim = (ni * lr - nr * li) / den; const float br = C.b_re[(size_t)g * 1024 + t], bi = C.b_im[(size_t)g * 1024 + t];
        BB[t * 2] = fre * br - fim * bi; BB[t * 2 + 1] = fre * bi + fim * br;
        CC[t * 2] = C.c_re[(size_t)g * 1024 + t]; CC[t * 2 + 1] = C.c_im[(size_t)g * 1024 + t]; }
    __syncthreads();
    { const int pair = C.tid & 255, nh = C.tid >> 8, cp = pair & 15, c = pair >> 4; float acc[16];
#pragma unroll
        for (int l = 0; l < 16; ++l) acc[l] = 0.f;
        for (int n = nh * 32; n < nh * 32 + 32; ++n) { const float cr = CC[(c * 64 + n) * 2], ci = CC[(c * 64 + n) * 2 + 1], br = BB[(n * 16 + cp) * 2], bi = BB[(n * 16 + cp) * 2 + 1];
            const float wr = cr * br - ci * bi, wi = cr * bi + ci * br;
#pragma unroll
            for (int l = 0; l < 16; ++l) acc[l] += wr * AP[(l * 64 + n) * 2] - wi * AP[(l * 64 + n) * 2 + 1]; }
        if (nh == 1) {
#pragma unroll
            for (int l = 0; l < 16; ++l) KT[l * 256 + pair] = acc[l]; }
        __syncthreads();
        if (nh == 0) {
#pragma unroll
            for (int l = 0; l < 16; ++l) KT[l * 256 + pair] += acc[l]; } }
    __syncthreads();
    for (int e = C.tid; e < 32 * 192; e += NTHR) { const int n = sub * 32 + e / 192, k0 = (e % 192) * 2, t = n >> 4, c = n & 15; float v[2];
#pragma unroll
        for (int q = 0; q < 2; ++q) { const int k = k0 + q;
            if (k < 256) { const int s = k >> 4, cp = k & 15; float x = 0.f; if (s <= t) { x = KT[((t - s) * 16 + c) * 16 + cp]; if (s == t && c == cp) x += C.s5d[g * 16 + c]; } v[q] = x; }
            else { const int nn = (k - 256) & 63, im = (k - 256) >> 6; const float cr = CC[(c * 64 + nn) * 2], ci = CC[(c * 64 + nn) * 2 + 1], ar = AP[((t + 1) * 64 + nn) * 2], ai = AP[((t + 1) * 64 + nn) * 2 + 1];
                v[q] = im ? -(cr * ai + ci * ar) : (cr * ar - ci * ai); } }
        *(unsigned*)(C.S5C + ((size_t)g * 256 + n) * 384 + k0) = pk2(v[0], v[1]); }
    for (int e = C.tid; e < 32 * 128; e += NTHR) { const int n = sub * 32 + e / 128, k0 = (e % 128) * 2; float v[2] = {0.f, 0.f};
        if (n < 128) { const int nn = n & 63, im = n >> 6;
#pragma unroll
            for (int q = 0; q < 2; ++q) { const int k = k0 + q, s = k >> 4, cp = k & 15; const float ar = AP[((15 - s) * 64 + nn) * 2], ai = AP[((15 - s) * 64 + nn) * 2 + 1], br = BB[(nn * 16 + cp) * 2], bi = BB[(nn * 16 + cp) * 2 + 1];
                v[q] = im ? (ar * bi + ai * br) : (ar * br - ai * bi); } }
        *(unsigned*)(C.S5A + ((size_t)g * 256 + n) * 256 + k0) = pk2(v[0], v[1]); }
    __syncthreads();
}
constexpr int LATE_GLU = 8 * 16, LATE_O = 16 * 32, LATE_POOL = 4 * 8, LATE_UP = 16 * 128, LATE_DN = 64 * 32, N_LATE = LATE_GLU + LATE_O + 4 * LATE_POOL + 2 * LATE_UP + 2 * LATE_DN;
constexpr int N_LATE_A = LATE_GLU + LATE_O + 4 * LATE_POOL + LATE_UP + LATE_DN, N_LATE_B = N_LATE_A + 3072;
static_assert(N_LATE_A % 8 == 0 && N_LATE_B % 8 == 0 && N_LATE_B < N_LATE, "late ranges");
__device__ __forceinline__ void late_weight_item(const Ctx& C, int it, LAS float* scr) {
    int r = it;
    if (r < LATE_GLU) { p0_transpose_item(C.w_glu, 512, 512, C.WGLU, 512, 0, nullptr, scr, r, C.lane); return; } r -= LATE_GLU;
    if (r < LATE_O) { p0_transpose_item(C.w_o, 1024, 1024, C.WO, 1024, 0, nullptr, scr, r, C.lane); return; } r -= LATE_O;
    if (r < 4 * LATE_POOL) { const int gi = r / LATE_POOL; p0_transpose_item(C.pool_w + (size_t)gi * 65536, 256, 256, C.POOLT, 256, gi * 256, nullptr, scr, r % LATE_POOL, C.lane); return; } r -= 4 * LATE_POOL;
    if (r < LATE_UP) { p0_transpose_item(C.w_up, 4096, 4096, C.WUP0, 1024, 0, C.norm_mlp, scr, r, C.lane); return; } r -= LATE_UP;
    if (r < LATE_DN) { p0_transpose_item(C.w_down, 1024, 1024, C.WDN0, 4096, 0, nullptr, scr, r, C.lane); return; } r -= LATE_DN;
    if (r < LATE_UP) { p0_transpose_item(C.w_up + (size_t)1024 * 4096, 4096, 4096, C.WUP1, 1024, 0, C.norm_mlp + 1024, scr, r, C.lane); return; } r -= LATE_UP;
    p0_transpose_item(C.w_down + (size_t)4096 * 1024, 1024, 1024, C.WDN1, 4096, 0, nullptr, scr, r, C.lane);
}
__device__ __forceinline__ void p0_prologue(const Ctx& C) {
    LAS float* scr = (LAS float*)(C.lds + RING_OFF + C.wave * 16384);
    const int gw = C.bid * NWAVES + C.wave, NGW = C.G * NWAVES;
#pragma unroll 1
    for (int pass = 0; pass < 2; ++pass) {
        if ((pass == 0) == (((C.bid >> 3) & 1) != 0)) {
            for (int j = C.bid; j < 256; j += C.G) p0_s5_group(C, j >> 3, 7 - (j & 7));
        } else {
            for (int it = gw; it < 16 * 64; it += NGW) p0_transpose_item(C.w_in, 2048, 2048, C.WIN, 1024, 0, C.norm_mix, scr, it, C.lane);
            for (int m = gw; m < RG; m += 4 * NGW) p0_rows4(C, m, NGW);
        }
        __syncthreads();
    }
    for (int i = C.bid * NTHR + C.tid; i < LP * 8; i += C.G * NTHR) { const int pos = i >> 3, j = i & 7; const float inv = powf(500000.0f, -(float)j / 8.0f), ang = (float)pos * inv; float sn, cs; sincosf(ang, &sn, &cs);
        C.ROPE[2 * i] = cs; C.ROPE[2 * i + 1] = sn; }
    for (int i = C.bid * NTHR + C.tid; i < 2 * 48 * 64; i += C.G * NTHR) { const int b = i / (48 * 64), rem = i % (48 * 64);
        ((u32x4*)(C.KB + (size_t)b * KROWS * 512))[rem] = (u32x4){0u, 0u, 0u, 0u}; ((u32x4*)(C.VB + (size_t)b * KROWS * 512))[rem] = (u32x4){0u, 0u, 0u, 0u}; }
}

struct NoPre {};
struct EpiProj {
    Ctx C; static constexpr int GM = 2;
    struct Pre { float rinv; f32x4 t[4]; }; typedef NoPre CPre;
    __device__ __forceinline__ CPre cpre(int) const { return CPre{}; }
    template <int XM> __device__ __forceinline__ Pre pre(int row, int col, int fq) const {
        Pre p; p.rinv = __builtin_amdgcn_rsqf(C.rowsq[row] * (1.0f / 1024.0f) + EPS);
        const bool rot = ((col >> 9) < 2) && ((col & 32) == 0) && (fq < 2) && (row < RVALID);
#pragma unroll
        for (int q = 0; q < 4; ++q) p.t[q] = (f32x4){1.f, 0.f, 1.f, 0.f};
        if (rot) { const f32x4* tp = (const f32x4*)(C.ROPE + (size_t)row_pos(row) * 16);
#pragma unroll
            for (int q = 0; q < 4; ++q) p.t[q] = tp[q]; }
        return p;
    }
    template <int XM> __device__ __forceinline__ float seg(int row, int col, const f32x4& a, const f32x4& d, int fq, const Pre& p, const CPre&) const {
        const int sec = col >> 9, csec = col & 511; const bool rot = (sec < 2) && ((csec & 32) == 0) && (fq < 2);
        float v[8];
#pragma unroll
        for (int j = 0; j < 4; ++j) { v[j] = a[j] * p.rinv; v[4 + j] = d[j] * p.rinv; }
        if (sec < 2) {
#pragma unroll
            for (int j = 0; j < 8; ++j) { const float cs = p.t[j >> 1][(j & 1) * 2], sn = p.t[j >> 1][(j & 1) * 2 + 1]; const float x = __shfl_xor(v[j], XM); if (rot) v[j] = (fq == 0) ? v[j] * cs - x * sn : v[j] * cs + x * sn; }
        }
        if (row >= RVALID) return 0.f;
        if (sec == 0) {
            u32x4 w; w.x = cvt_pk_bf16(v[0] * C2, v[1] * C2); w.y = cvt_pk_bf16(v[2] * C2, v[3] * C2); w.z = cvt_pk_bf16(v[4] * C2, v[5] * C2); w.w = cvt_pk_bf16(v[6] * C2, v[7] * C2);
            *(u32x4*)(C.QB + (size_t)row * 512 + csec) = w;
        } else if (sec < 3) {
            const f32x4 lo = {v[0], v[1], v[2], v[3]}, hi = {v[4], v[5], v[6], v[7]};
            u32x4 w; w.x = cvt_pk_bf16(v[0], v[1]); w.y = cvt_pk_bf16(v[2], v[3]); w.z = cvt_pk_bf16(v[4], v[5]); w.w = cvt_pk_bf16(v[6], v[7]);
            bf16_t* KV = sec == 1 ? C.KB : C.VB; float* OP = C.out + (sec == 1 ? O_KP : O_VP); float* OS = C.out + (sec == 1 ? O_KS : O_VS);
            if (row < NMAIN) { const int b = row >> 13, i = row & (SEQ - 1);
                float* o = OP + ((size_t)b * LP + NMETA + i) * 512 + csec; *(f32x4*)o = lo; *(f32x4*)(o + 4) = hi;
                *(u32x4*)(KV + ((size_t)b * KROWS + 64 + i) * 512 + csec) = w;
            } else if (row < XR0 + NMETA) { const int j = row - XR0;
#pragma unroll
                for (int b = 0; b < 2; ++b) { float* o = OP + ((size_t)b * LP + j) * 512 + csec; *(f32x4*)o = lo; *(f32x4*)(o + 4) = hi;
                    *(u32x4*)(KV + ((size_t)b * KROWS + 48 + j) * 512 + csec) = w; }
            } else { float* o = OS + (size_t)(row - XR0 - NMETA) * 512 + csec; *(f32x4*)o = lo; *(f32x4*)(o + 4) = hi; }
        } else {
            if (row < NMAIN) { const int b = row >> 13, i = row & (SEQ - 1), g = csec >> 4, c0 = csec & 15;
                u32x4 w; w.x = cvt_pk_bf16(v[0], v[1]); w.y = cvt_pk_bf16(v[2], v[3]); w.z = cvt_pk_bf16(v[4], v[5]); w.w = cvt_pk_bf16(v[6], v[7]);
                *(u32x4*)(C.A2 + ((size_t)g * 1024 + b * 512 + (i >> 4)) * 384 + (i & 15) * 16 + c0) = w;
            } else { float* o = C.UX + (size_t)(row - XR0) * 512 + csec; *(f32x4*)o = (f32x4){v[0], v[1], v[2], v[3]}; *(f32x4*)(o + 4) = (f32x4){v[4], v[5], v[6], v[7]}; }
        }
        return 0.f;
    }
    template <int XM> __device__ __forceinline__ void finish(int, float, int) const {}
};
__device__ __forceinline__ float gelu_tanh(float x) { const float t2 = -2.302208198f * (x + 0.044715f * x * x * x); return x * __builtin_amdgcn_rcpf(1.0f + __builtin_amdgcn_exp2f(t2)); }
struct EpiGlu {
    Ctx C; static constexpr int GM = 4;
    struct Pre { u32x4 y; }; struct CPre { f32x4 b0, b1; };
    __device__ __forceinline__ CPre cpre(int col) const { return CPre{*(const f32x4*)(C.b_glu + col), *(const f32x4*)(C.b_glu + col + 4)}; }
    template <int XM> __device__ __forceinline__ Pre pre(int row, int col, int) const { return Pre{*(const u32x4*)(C.YS + (size_t)row * 512 + col)}; }
    template <int XM> __device__ __forceinline__ float seg(int row, int col, const f32x4& a0, const f32x4& d0, int, const Pre& p, const CPre& cp) const {
        const f32x4 a = a0 + cp.b0, d = d0 + cp.b1; const u32x4 y = p.y; float o[8];
        o[0] = bflo(y.x) * __builtin_amdgcn_rcpf(1.f + __expf(-a[0])); o[1] = bfhi(y.x) * __builtin_amdgcn_rcpf(1.f + __expf(-a[1])); o[2] = bflo(y.y) * __builtin_amdgcn_rcpf(1.f + __expf(-a[2])); o[3] = bfhi(y.y) * __builtin_amdgcn_rcpf(1.f + __expf(-a[3]));
        o[4] = bflo(y.z) * __builtin_amdgcn_rcpf(1.f + __expf(-d[0])); o[5] = bfhi(y.z) * __builtin_amdgcn_rcpf(1.f + __expf(-d[1])); o[6] = bflo(y.w) * __builtin_amdgcn_rcpf(1.f + __expf(-d[2])); o[7] = bfhi(y.w) * __builtin_amdgcn_rcpf(1.f + __expf(-d[3]));
        u32x4 w; w.x = cvt_pk_bf16(o[0], o[1]); w.y = cvt_pk_bf16(o[2], o[3]); w.z = cvt_pk_bf16(o[4], o[5]); w.w = cvt_pk_bf16(o[6], o[7]);
        *(u32x4*)(C.CAT + (size_t)row * 1024 + 512 + col) = w; return 0.f;
    }
    template <int XM> __device__ __forceinline__ void finish(int, float, int) const {}
};
template <int MODE> struct EpiResid {
    Ctx C; int slot; bf16_t* XO; const bf16_t* XI;     static constexpr int GM = 4;
    struct Pre { u32x4 x; }; struct CPre { f32x4 pb0, pb1, ps0, ps1; };
    __device__ __forceinline__ CPre cpre(int col) const { CPre c; if (MODE == 2) { c.pb0 = *(const f32x4*)(C.pool_b + col); c.pb1 = *(const f32x4*)(C.pool_b + col + 4); c.ps0 = *(const f32x4*)(C.pool_scale + col); c.ps1 = *(const f32x4*)(C.pool_scale + col + 4); }
        else { c.pb0 = (f32x4){0.f, 0.f, 0.f, 0.f}; c.pb1 = c.pb0; c.ps0 = c.pb0; c.ps1 = c.pb0; } return c; }
    template <int XM> __device__ __forceinline__ Pre pre(int row, int col, int) const { Pre p;
        p.x = *(const u32x4*)(XI + (size_t)row * 1024 + col);
        return p; }
    template <int XM> __device__ __forceinline__ float seg(int row, int col, const f32x4& a0, const f32x4& d0, int, const Pre& p, const CPre& cp) const {
        f32x4 a = a0, d = d0;
        if (MODE == 2) { a = (a + cp.pb0) * cp.ps0; d = (d + cp.pb1) * cp.ps1; }
        { const u32x4 x = p.x; a += (f32x4){bflo(x.x), bfhi(x.x), bflo(x.y), bfhi(x.y)}; d += (f32x4){bflo(x.z), bfhi(x.z), bflo(x.w), bfhi(x.w)}; }
        u32x4 w; w.x = cvt_pk_bf16(a[0], a[1]); w.y = cvt_pk_bf16(a[2], a[3]); w.z = cvt_pk_bf16(d[0], d[1]); w.w = cvt_pk_bf16(d[2], d[3]); *(u32x4*)(XO + (size_t)row * 1024 + col) = w;
        return (a[0] * a[0] + a[1] * a[1]) + (a[2] * a[2] + a[3] * a[3]) + (d[0] * d[0] + d[1] * d[1]) + (d[2] * d[2] + d[3] * d[3]);
    }
    template <int XM> __device__ __forceinline__ void finish(int row, float ss, int fq) const { ss += __shfl_xor(ss, XM); ss += __shfl_xor(ss, 2 * XM); if (fq == 0) atomicAdd(C.rowsq + (size_t)slot * RG + row, ss); }
};
struct EpiUp {
    Ctx C; int slot; static constexpr int GM = 4;
    struct Pre { float rinv; }; typedef NoPre CPre;
    __device__ __forceinline__ CPre cpre(int) const { return CPre{}; }
    template <int XM> __device__ __forceinline__ Pre pre(int row, int, int) const { return Pre{__builtin_amdgcn_rsqf(C.rowsq[(size_t)slot * RG + row] * (1.0f / 1024.0f) + EPS)}; }
    template <int XM> __device__ __forceinline__ float seg(int row, int col, const f32x4& a, const f32x4& d, int, const Pre& p, const CPre&) const {
        float o[8];
#pragma unroll
        for (int j = 0; j < 4; ++j) { const float x = fmaxf(a[j] * p.rinv, 0.f), y = fmaxf(d[j] * p.rinv, 0.f); o[j] = x * x; o[4 + j] = y * y; }
        u32x4 w; w.x = cvt_pk_bf16(o[0], o[1]); w.y = cvt_pk_bf16(o[2], o[3]); w.z = cvt_pk_bf16(o[4], o[5]); w.w = cvt_pk_bf16(o[6], o[7]);
        *(u32x4*)(C.HB + (size_t)row * DFF + col) = w; return 0.f;
    }
    template <int XM> __device__ __forceinline__ void finish(int, float, int) const {}
};
__device__ __forceinline__ f32x4 lane_perm4(const f32x4& v, int srca) {
    const float x = __int_as_float(__builtin_amdgcn_ds_bpermute(srca, __float_as_int(v.x))), y = __int_as_float(__builtin_amdgcn_ds_bpermute(srca, __float_as_int(v.y)));
    const float z = __int_as_float(__builtin_amdgcn_ds_bpermute(srca, __float_as_int(v.z))), w = __int_as_float(__builtin_amdgcn_ds_bpermute(srca, __float_as_int(v.w)));
    return (f32x4){x, y, z, w};
}
template <class SE> struct EpiTile {
    SE E;
    __device__ __forceinline__ void operator()(const f32x4 (&acc)[2][2][4][2], const Unit& u, int wr, int wc, int fr, int fq) const {
        const int L = fq * 16 + fr, srca = (((L & 3) << 4) | (L >> 2)) << 2, fr2 = L >> 2, fq2 = L & 3;
        constexpr int GM = SE::GM;
        const int col0 = u.pn * 256 + wc * 32 + 8 * fq2, rowb = u.pm * 256 + wr * 64 + fr2;
        typename SE::CPre cp[2] = {E.cpre(col0), E.cpre(col0 + 128)};
#pragma unroll
        for (int ai = 0; ai < 2; ++ai)
#pragma unroll
            for (int mg = 0; mg < 4; mg += GM) {
                typename SE::Pre pre[GM][2];
#pragma unroll
                for (int mm = 0; mm < GM; ++mm)
#pragma unroll
                    for (int bj = 0; bj < 2; ++bj) pre[mm][bj] = E.template pre<1>(rowb + ai * 128 + (mg + mm) * 16, col0 + bj * 128, fq2);
#pragma unroll
                for (int mm = 0; mm < GM; ++mm) { const int m = mg + mm, row = rowb + ai * 128 + m * 16; float ss = 0.f;
#pragma unroll
                    for (int bj = 0; bj < 2; ++bj) ss += E.template seg<1>(row, col0 + bj * 128, lane_perm4(acc[ai][bj][m][0], srca), lane_perm4(acc[ai][bj][m][1], srca), fq2, pre[mm][bj], cp[bj]);
                    E.template finish<1>(row, ss, fq2); } }
    }
};
struct EpiFinal {
    Ctx C; unsigned* pcnt;
    __device__ __forceinline__ void operator()(f32x4 (&acc)[2][2][4][2], const Unit& u, int wr, int wc, int fr, int fq) const {
        const int L = fq * 16 + fr, srca = (((L & 3) << 4) | (L >> 2)) << 2, fr2 = L >> 2, fq2 = L & 3;
        const int col0 = u.pn * 256 + wc * 32 + 8 * fq2, rowb = u.pm * 256 + wr * 64 + fr2;
        float* rs = C.rowsq + (size_t)4 * RG;
#pragma unroll
        for (int ai = 0; ai < 2; ++ai) {
            u32x4 pre[4][2];
#pragma unroll
            for (int m = 0; m < 4; ++m)
#pragma unroll
                for (int bj = 0; bj < 2; ++bj) pre[m][bj] = *(const u32x4*)(C.XB2 + (size_t)(rowb + ai * 128 + m * 16) * 1024 + col0 + bj * 128);
#pragma unroll
            for (int m = 0; m < 4; ++m) { const int row = rowb + ai * 128 + m * 16; float ss = 0.f;
#pragma unroll
                for (int bj = 0; bj < 2; ++bj) { f32x4 a = lane_perm4(acc[ai][bj][m][0], srca), d = lane_perm4(acc[ai][bj][m][1], srca); const u32x4 x = pre[m][bj];
                    a += (f32x4){bflo(x.x), bfhi(x.x), bflo(x.y), bfhi(x.y)}; d += (f32x4){bflo(x.z), bfhi(x.z), bflo(x.w), bfhi(x.w)};
                    acc[ai][bj][m][0] = a; acc[ai][bj][m][1] = d;
                    ss += (a[0] * a[0] + a[1] * a[1]) + (a[2] * a[2] + a[3] * a[3]) + (d[0] * d[0] + d[1] * d[1]) + (d[2] * d[2] + d[3] * d[3]); }
                ss += __shfl_xor(ss, 1); ss += __shfl_xor(ss, 2); if (fq2 == 0) atomicAdd(rs + row, ss); } }
        asm volatile("s_waitcnt vmcnt(0)" ::: "memory"); __builtin_amdgcn_s_barrier(); asm volatile("" ::: "memory");
        if (threadIdx.x == 0) __hip_atomic_fetch_add(pcnt + 64 * u.pm, 1u, RLX_AGENT);
        if (wr == 0 && wc == 0) { unsigned sp = 0; while (__hip_atomic_load(pcnt + 64 * u.pm, RLX_AGENT) < 4u && ++sp < (1u << 22)) __builtin_amdgcn_s_sleep(1);
            __builtin_amdgcn_fence(__ATOMIC_ACQUIRE, "agent"); }
        asm volatile("s_waitcnt vmcnt(0)" ::: "memory"); __builtin_amdgcn_s_barrier(); asm volatile("" ::: "memory");
        f32x4 g[2][2];
#pragma unroll
        for (int bj = 0; bj < 2; ++bj) { g[bj][0] = *(const f32x4*)(C.norm_final + col0 + bj * 128); g[bj][1] = *(const f32x4*)(C.norm_final + col0 + bj * 128 + 4); }
#pragma unroll
        for (int ai = 0; ai < 2; ++ai) {
            float ri[4];
#pragma unroll
            for (int m = 0; m < 4; ++m) ri[m] = __builtin_amdgcn_rsqf(__uint_as_float(__hip_atomic_load((unsigned*)(rs + rowb + ai * 128 + m * 16), RLX_AGENT)) * (1.0f / 1024.0f) + EPS);
#pragma unroll
            for (int m = 0; m < 4; ++m) { float* o = C.out + O_YP + (size_t)(rowb + ai * 128 + m * 16) * 1024 + col0;
#pragma unroll
                for (int bj = 0; bj < 2; ++bj) { *(f32x4*)(o + bj * 128) = acc[ai][bj][m][0] * ri[m] * g[bj][0]; *(f32x4*)(o + bj * 128 + 4) = acc[ai][bj][m][1] * ri[m] * g[bj][1]; } } }
    }
};
#define EPI_ROWS(u, ai, m) ((u).pm * 256 + (ai) * 128 + wr * 64 + (m) * 16 + fr)
struct EpiS5a {
    Ctx C;
    __device__ __forceinline__ void operator()(const f32x4 (&acc)[2][2][4][2], const Unit& u, int wr, int wc, int fr, int fq) const {
#pragma unroll
        for (int ai = 0; ai < 2; ++ai)
#pragma unroll
            for (int m = 0; m < 4; ++m) { const int row = EPI_ROWS(u, ai, m); const int col = wc * 32 + 8 * fq;
                float* o = C.S5S + ((size_t)u.pb * 1024 + row) * 128 + col; *(f32x4*)o = acc[ai][0][m][0]; *(f32x4*)(o + 4) = acc[ai][0][m][1]; }
    }
};
struct EpiS5c {
    Ctx C;
    __device__ __forceinline__ void operator()(const f32x4 (&acc)[2][2][4][2], const Unit& u, int wr, int wc, int fr, int fq) const {
#pragma unroll
        for (int ai = 0; ai < 2; ++ai)
#pragma unroll
            for (int m = 0; m < 4; ++m) { const int cr = EPI_ROWS(u, ai, m), b = cr >> 9, j = cr & 511;
#pragma unroll
                for (int bj = 0; bj < 2; ++bj) { const int n = bj * 128 + wc * 32 + 8 * fq, t = n >> 4, c0 = n & 15; const f32x4 a = acc[ai][bj][m][0], d = acc[ai][bj][m][1];
                    u32x4 w; w.x = cvt_pk_bf16(gelu_tanh(a[0]), gelu_tanh(a[1])); w.y = cvt_pk_bf16(gelu_tanh(a[2]), gelu_tanh(a[3])); w.z = cvt_pk_bf16(gelu_tanh(d[0]), gelu_tanh(d[1])); w.w = cvt_pk_bf16(gelu_tanh(d[2]), gelu_tanh(d[3]));
                    *(u32x4*)(C.YS + ((size_t)b * SEQ + 16 * j + t) * 512 + u.pb * 16 + c0) = w; } }
    }
};
template <int RC, int PL, class SE>
__device__ __forceinline__ void xgemm(const Ctx& C, const bf16_t* A, int lda, const bf16_t* Bt, int ldb, int N, int K, int a_blk, const SE& E, LAS unsigned char* lds) {
    constexpr int LR = PL / 8, RPL = 64 / LR, NA = RC * 16 / RPL, NB = 32 / RPL, RS = PL * 2 + 16, KS = PL / 32;
    static_assert((RC * 16) % RPL == 0 && (RC * 16 + 32) * RS <= 16384 && RC * 2 * 1024 <= 16384, "xgemm geometry");
    typedef __attribute__((address_space(3))) const bf16x8* lfrag;
    const int ncg = N / 32, nunits = ncg * (10 / RC), fr = C.lane & 15, fq = C.lane >> 4, kw = K / 8, k0 = C.wave * kw, np = kw / PL;
    const int lrow = C.lane / LR, lpc = C.lane % LR;
    LAS unsigned char* st = lds + C.wave * 16384;
    LAS f32x4* red = (LAS f32x4*)st;
    for (int u = C.bid; u < nunits; u += C.G) {
        const int cg = u % ncg, rc = u / ncg;
        f32x4 acc[RC][2];
#pragma unroll
        for (int r = 0; r < RC; ++r) { acc[r][0] = (f32x4){0.f, 0.f, 0.f, 0.f}; acc[r][1] = (f32x4){0.f, 0.f, 0.f, 0.f}; }
        const bf16_t* ap = A + (size_t)(XR0 + rc * RC * 16 + lrow) * lda + (size_t)(cg >> 3) * a_blk + k0 + 8 * lpc;
        const bf16_t* bp = Bt + (size_t)(32 * cg + lrow) * ldb + k0 + 8 * lpc;
        u32x4 ra[NA], rb[NB], na[NA], nb[NB];
#pragma unroll
        for (int j = 0; j < NA; ++j) na[j] = *(const u32x4*)(ap + (size_t)j * RPL * lda);
#pragma unroll
        for (int j = 0; j < NB; ++j) nb[j] = *(const u32x4*)(bp + (size_t)j * RPL * ldb);
#pragma unroll 1
        for (int p = 0; p < np; ++p) {
#pragma unroll
            for (int j = 0; j < NA; ++j) ra[j] = na[j];
#pragma unroll
            for (int j = 0; j < NB; ++j) rb[j] = nb[j];
            if (p + 1 < np) {
#pragma unroll
                for (int j = 0; j < NA; ++j) na[j] = *(const u32x4*)(ap + (size_t)j * RPL * lda + (p + 1) * PL);
#pragma unroll
                for (int j = 0; j < NB; ++j) nb[j] = *(const u32x4*)(bp + (size_t)j * RPL * ldb + (p + 1) * PL); }
#pragma unroll
            for (int j = 0; j < NA; ++j) *(LAS u32x4*)(st + (j * RPL + lrow) * RS + lpc * 16) = ra[j];
#pragma unroll
            for (int j = 0; j < NB; ++j) *(LAS u32x4*)(st + (RC * 16 + j * RPL + lrow) * RS + lpc * 16) = rb[j];
            asm volatile("s_waitcnt lgkmcnt(0)" ::: "memory");
#pragma unroll
            for (int s = 0; s < KS; ++s) {
                const bf16x8 b0 = *(lfrag)(st + (RC * 16 + 8 * (fr >> 2) + (fr & 3)) * RS + s * 64 + fq * 16), b1 = *(lfrag)(st + (RC * 16 + 8 * (fr >> 2) + 4 + (fr & 3)) * RS + s * 64 + fq * 16);
#pragma unroll
                for (int r = 0; r < RC; ++r) { const bf16x8 af = *(lfrag)(st + (r * 16 + fr) * RS + s * 64 + fq * 16);
                    acc[r][0] = __builtin_amdgcn_mfma_f32_16x16x32_bf16(b0, af, acc[r][0], 0, 0, 0); acc[r][1] = __builtin_amdgcn_mfma_f32_16x16x32_bf16(b1, af, acc[r][1], 0, 0, 0); } }
            asm volatile("s_waitcnt lgkmcnt(0)" ::: "memory");
        }
#pragma unroll
        for (int r = 0; r < RC; ++r) { red[(r * 2 + 0) * 64 + C.lane] = acc[r][0]; red[(r * 2 + 1) * 64 + C.lane] = acc[r][1]; }
        __syncthreads();
        if (C.wave < RC) { const int r = C.wave; f32x4 a = (f32x4){0.f, 0.f, 0.f, 0.f}, d = a;
#pragma unroll
            for (int w = 0; w < 8; ++w) { const LAS f32x4* rw = (const LAS f32x4*)(lds + w * 16384); a += rw[(r * 2 + 0) * 64 + C.lane]; d += rw[(r * 2 + 1) * 64 + C.lane]; }
            const int row = XR0 + (rc * RC + r) * 16 + fr, col = 32 * cg + 8 * fq; const typename SE::CPre cp = E.cpre(col); const typename SE::Pre pr = E.template pre<16>(row, col, fq);
            const float ss = E.template seg<16>(row, col, a, d, fq, pr, cp); E.template finish<16>(row, ss, fq); }
        __syncthreads();
    }
}
}

namespace mk {
__device__ __forceinline__ float reduce16(float (&v)[16], int lane) {
    float w8[8], w4[4], w2[2], w1;
    { const bool up = lane & 32;
#pragma unroll
      for (int i = 0; i < 8; ++i) { const float snd = up ? v[i] : v[i + 8], keep = up ? v[i + 8] : v[i]; w8[i] = keep + __shfl_xor(snd, 32); } }
    { const bool up = lane & 16;
#pragma unroll
      for (int i = 0; i < 4; ++i) { const float snd = up ? w8[i] : w8[i + 4], keep = up ? w8[i + 4] : w8[i]; w4[i] = keep + __shfl_xor(snd, 16); } }
    { const bool up = lane & 8;
#pragma unroll
      for (int i = 0; i < 2; ++i) { const float snd = up ? w4[i] : w4[i + 2], keep = up ? w4[i + 2] : w4[i]; w2[i] = keep + __shfl_xor(snd, 8); } }
    { const bool up = lane & 4; const float snd = up ? w2[0] : w2[1], keep = up ? w2[1] : w2[0]; w1 = keep + __shfl_xor(snd, 4); }
    w1 += __shfl_xor(w1, 1); w1 += __shfl_xor(w1, 2); return w1;
}
__device__ __forceinline__ void s5x_item(const Ctx& C, int item) {
    const int g = item & 31, seq = item >> 5, n = C.lane;
    const float lr = C.lam_re[g * 64 + n], li = C.lam_im[g * 64 + n], dt = expf(C.log_dt[g]);
    const float mag = expf(lr * dt); float sn, cs; sincosf(li * dt, &sn, &cs); const float are = mag * cs, aim = mag * sn;
    const float nr = are - 1.0f, ni = aim, den = lr * lr + li * li, fre = (nr * lr + ni * li) / den, fim = (ni * lr - nr * li) / den;
    float bbr[16], bbi[16], ccr[16], cci[16];
#pragma unroll
    for (int c = 0; c < 16; ++c) { const float br = C.b_re[((size_t)g * 64 + n) * 16 + c], bi = C.b_im[((size_t)g * 64 + n) * 16 + c]; bbr[c] = fre * br - fim * bi; bbi[c] = fre * bi + fim * br;
        ccr[c] = C.c_re[((size_t)g * 16 + c) * 64 + n]; cci[c] = C.c_im[((size_t)g * 16 + c) * 64 + n]; }
    float hr = 0.f, hi = 0.f; int L = NMETA, x0 = 0;
    if (seq > 0) { const int sb = seq - 1; hr = C.st_re[((size_t)sb * 32 + g) * 64 + n]; hi = C.st_im[((size_t)sb * 32 + g) * 64 + n]; L = 4; x0 = NMETA + sb * 4; }
    const int cme = ((n >> 5) & 1) * 8 + ((n >> 4) & 1) * 4 + ((n >> 3) & 1) * 2 + ((n >> 2) & 1);
    const float dme = C.s5d[g * 16 + cme];
    f32x4 un[4]; { const f32x4* up = (const f32x4*)(C.UX + (size_t)x0 * 512 + g * 16); un[0] = up[0]; un[1] = up[1]; un[2] = up[2]; un[3] = up[3]; }
    for (int t = 0; t < L; ++t) {
        float uv[16];
#pragma unroll
        for (int c = 0; c < 16; ++c) uv[c] = un[c >> 2][c & 3];
        if (t + 1 < L) { const f32x4* up = (const f32x4*)(C.UX + (size_t)(x0 + t + 1) * 512 + g * 16); un[0] = up[0]; un[1] = up[1]; un[2] = up[2]; un[3] = up[3]; }
        float ur = 0.f, ui = 0.f;
#pragma unroll
        for (int c = 0; c < 16; ++c) { ur += bbr[c] * uv[c]; ui += bbi[c] * uv[c]; }
        const float tr = are * hr - aim * hi + ur, ti = are * hi + aim * hr + ui; hr = tr; hi = ti;
        float pv[16];
#pragma unroll
        for (int c = 0; c < 16; ++c) pv[c] = ccr[c] * hr - cci[c] * hi;
        const float ysum = reduce16(pv, n);
        float ume = 0.f;
#pragma unroll
        for (int c = 0; c < 16; ++c) ume = (c == cme) ? uv[c] : ume;
        if ((n & 3) == 0) C.YS[(size_t)(XR0 + x0 + t) * 512 + g * 16 + cme] = (bf16_t)f2bf(gelu_tanh(ysum + dme * ume));
    }
    if (seq == 0) { C.SMETA[(g * 64 + n) * 2] = hr; C.SMETA[(g * 64 + n) * 2 + 1] = hi; }
    else { const int sb = seq - 1; C.out[O_RS + ((size_t)sb * 32 + g) * 64 + n] = hr; C.out[O_IS + ((size_t)sb * 32 + g) * 64 + n] = hi; }
}
__device__ __forceinline__ void meta_attn_item(const Ctx& C, int item) {
    const int hm = item & 7, j = item >> 3, head = hm >> 1, m = hm & 1, lane = C.lane, k = lane & 15, dp = lane >> 4;
    const u32x4* qp = (const u32x4*)(C.QB + (size_t)(XR0 + j) * 512 + hm * 64 + dp * 16); const u32x4* kp = (const u32x4*)(C.KB + (size_t)(48 + k) * 512 + hm * 64 + dp * 16);
    float a = 0.f;
#pragma unroll
    for (int q = 0; q < 2; ++q) { const u32x4 x = qp[q], y = kp[q];
        a += bflo(x.x) * bflo(y.x) + bfhi(x.x) * bfhi(y.x) + bflo(x.y) * bflo(y.y) + bfhi(x.y) * bfhi(y.y) + bflo(x.z) * bflo(y.z) + bfhi(x.z) * bfhi(y.z) + bflo(x.w) * bflo(y.w) + bfhi(x.w) * bfhi(y.w); }
    a += __shfl_xor(a, 16); a += __shfl_xor(a, 32);
    const float s = (k <= j) ? a : -INFINITY; float mx = s;
    mx = fmaxf(mx, __shfl_xor(mx, 1)); mx = fmaxf(mx, __shfl_xor(mx, 2)); mx = fmaxf(mx, __shfl_xor(mx, 4)); mx = fmaxf(mx, __shfl_xor(mx, 8));
    const float p = __builtin_amdgcn_exp2f(s - mx); float l = p; l += __shfl_xor(l, 1); l += __shfl_xor(l, 2); l += __shfl_xor(l, 4); l += __shfl_xor(l, 8);
    float o0 = 0.f, o1 = 0.f;
#pragma unroll
    for (int kk = 0; kk < 16; ++kk) { const float pk = __shfl(p, kk); const unsigned v = *(const unsigned*)(C.VB + (size_t)(48 + kk) * 512 + head * 128 + 2 * lane); o0 += pk * bflo(v); o1 += pk * bfhi(v); }
    const float il = 1.0f / l; *(unsigned*)((m ? C.O2 : C.O1) + (size_t)(XR0 + j) * 512 + head * 128 + 2 * lane) = pk2(o0 * il, o1 * il);
}
__device__ __forceinline__ void s5_scan_item(const Ctx& C, int item) {
    const int g = item & 31, b = item >> 5, n = C.lane;
    const float lr = C.lam_re[g * 64 + n], li = C.lam_im[g * 64 + n], dt = expf(C.log_dt[g]);
    const float mag = expf(16.0f * lr * dt); float sn, cs; sincosf(16.0f * li * dt, &sn, &cs); const float are = mag * cs, aim = mag * sn;
    float hr = C.SMETA[(g * 64 + n) * 2], hi = C.SMETA[(g * 64 + n) * 2 + 1];
    const float* S = C.S5S + ((size_t)g * 1024 + b * 512) * 128 + n; bf16_t* H = C.A2 + ((size_t)g * 1024 + b * 512) * 384 + 256 + n;
    float sr[16], si[16], nr[16], ni[16];
#pragma unroll
    for (int k = 0; k < 16; ++k) { nr[k] = S[(size_t)k * 128]; ni[k] = S[(size_t)k * 128 + 64]; }
#pragma unroll 1
    for (int j0 = 0; j0 < 512; j0 += 16) {
#pragma unroll
        for (int k = 0; k < 16; ++k) { sr[k] = nr[k]; si[k] = ni[k]; }
        if (j0 + 16 < 512) {
#pragma unroll
            for (int k = 0; k < 16; ++k) { nr[k] = S[(size_t)(j0 + 16 + k) * 128]; ni[k] = S[(size_t)(j0 + 16 + k) * 128 + 64]; } }
#pragma unroll
        for (int k = 0; k < 16; ++k) { H[(size_t)(j0 + k) * 384] = (bf16_t)f2bf(hr); H[(size_t)(j0 + k) * 384 + 64] = (bf16_t)f2bf(hi);
            const float tr = are * hr - aim * hi + sr[k], ti = are * hi + aim * hr + si[k]; hr = tr; hi = ti; } }
    C.out[O_RP + ((size_t)b * 32 + g) * 64 + n] = hr; C.out[O_IP + ((size_t)b * 32 + g) * 64 + n] = hi;
}
template <bool DUMMY> __device__ __forceinline__ void decode_item(const Ctx& C, int item, LAS unsigned char* ldsb) {
    typedef __attribute__((address_space(3))) const char* lcp;
    constexpr int VST = 272;
    item = __builtin_amdgcn_readfirstlane(item);
    const int sb = item / NDIT, it8 = item % NDIT, h = C.wave & 3, th = C.wave >> 2, lane = C.lane, jq = lane & 15, fq = lane >> 4, par = lane >> 5, l32 = lane & 31;
    LAS unsigned char* Vb = ldsb + C.wave * 14336;
    LAS unsigned char* Kb = Vb + 16 * VST;
    LAS unsigned char* Pb = Kb + 16 * VST;
    LAS float* Al = (LAS float*)(Pb + 1024);
    LAS bf16x8* Qs = (LAS bf16x8*)(Pb + 1024 + 64);
    for (int i = lane; i < 1024 / 4; i += 64) ((LAS unsigned*)Pb)[i] = 0u;
    if (lane < 16) Al[lane] = 1.0f;
#pragma unroll
    for (int m = 0; m < 2; ++m)
#pragma unroll
        for (int ks = 0; ks < 2; ++ks) { bf16x8 q = (bf16x8){0, 0, 0, 0, 0, 0, 0, 0}; if (jq < 4) q = *(const bf16x8*)(C.QB + (size_t)(XR0 + NMETA + sb * 4 + jq) * 512 + (h * 2 + m) * 64 + ks * 32 + fq * 8); Qs[(m * 2 + ks) * 64 + lane] = q; }
    float mrun[2] = {-INFINITY, -INFINITY}, lrun[2] = {0.f, 0.f};
    f32x4 o[8];
#pragma unroll
    for (int db = 0; db < 8; ++db) o[db] = (f32x4){0.f, 0.f, 0.f, 0.f};
    const lcp vrd = (lcp)Vb + (8 * (fq & 1) + (jq >> 2)) * VST + (jq & 3) * 8;
    const lcp krd = (lcp)Kb + jq * VST + fq * 16;
    const lcp prd = (lcp)Pb + jq * 64 + fq * 16;
    const __attribute__((address_space(4))) int* pt4 = (const __attribute__((address_space(4))) int*)(unsigned long long)C.page_table;
    f32x4 kA[8], vA[8], kB[8], vB[8];
#define DEC_ISSUE(t, KN, VN) do { const size_t page_ = (size_t)pt4[__builtin_amdgcn_readfirstlane(DUMMY ? (C.bid & 7) : sb * NPAGES + it8 * NDPG + ((t) >> 2))];     \
        const float* Kt_ = C.cache_k + (page_ * 128 + th * 64 + ((t) & 3) * 16) * 512 + h * 128; const float* Vt_ = C.cache_v + (page_ * 128 + th * 64 + ((t) & 3) * 16) * 512 + h * 128; \
        _Pragma("unroll") for (int i = 0; i < 8; ++i) KN[i] = __builtin_nontemporal_load((const f32x4*)(Kt_ + (size_t)(2 * i + par) * 512 + l32 * 4));     \
        _Pragma("unroll") for (int i = 0; i < 8; ++i) VN[i] = __builtin_nontemporal_load((const f32x4*)(Vt_ + (size_t)(2 * i + par) * 512 + l32 * 4)); } while (0)
#define DEC_CONSUME(KR, VR) do { \
        _Pragma("unroll") for (int i = 0; i < 8; ++i) { const f32x4 v = KR[i]; u32x2 w; w.x = cvt_pk_bf16(v[0], v[1]); w.y = cvt_pk_bf16(v[2], v[3]); \
            *(LAS u32x2*)(Kb + (2 * i + par) * VST + l32 * 8) = w; } \
        _Pragma("unroll") for (int i = 0; i < 8; ++i) { const f32x4 v = VR[i]; u32x2 w; w.x = cvt_pk_bf16(v[0], v[1]); w.y = cvt_pk_bf16(v[2], v[3]); \
            *(LAS u32x2*)(Vb + (2 * i + par) * VST + l32 * 8) = w; } } while (0)
#define DEC_COMPUTE() do { \
        float alpha[2]; \
        _Pragma("unroll") for (int m = 0; m < 2; ++m) { \
            f32x4 s = (f32x4){0.f, 0.f, 0.f, 0.f}; \
            s = __builtin_amdgcn_mfma_f32_16x16x32_bf16(*(const __attribute__((address_space(3))) bf16x8*)(krd + m * 128), Qs[(m * 2 + 0) * 64 + lane], s, 0, 0, 0); \
            s = __builtin_amdgcn_mfma_f32_16x16x32_bf16(*(const __attribute__((address_space(3))) bf16x8*)(krd + m * 128 + 64), Qs[(m * 2 + 1) * 64 + lane], s, 0, 0, 0); \
            float mloc = fmaxf(fmaxf(s[0], s[1]), fmaxf(s[2], s[3])); mloc = fmaxf(mloc, __shfl_xor(mloc, 16)); mloc = fmaxf(mloc, __shfl_xor(mloc, 32)); \
            const float mnew = fmaxf(mrun[m], mloc); alpha[m] = __builtin_amdgcn_exp2f(mrun[m] - mnew); mrun[m] = mnew; \
            const float p0_ = __builtin_amdgcn_exp2f(s[0] - mnew), p1_ = __builtin_amdgcn_exp2f(s[1] - mnew), p2_ = __builtin_amdgcn_exp2f(s[2] - mnew), p3_ = __builtin_amdgcn_exp2f(s[3] - mnew); \
            lrun[m] = lrun[m] * alpha[m] + ((p0_ + p1_) + (p2_ + p3_)); \
            if (jq < 4) { u32x2 w; w.x = cvt_pk_bf16(p0_, p1_); w.y = cvt_pk_bf16(p2_, p3_); *(LAS u32x2*)(Pb + (m * 4 + jq) * 64 + 8 * fq) = w; if (fq == 0) Al[m * 4 + jq] = alpha[m]; } \
        } \
        const bool resc = __any((jq < 4) && (alpha[0] != 1.0f || alpha[1] != 1.0f)); \
        asm volatile("s_waitcnt lgkmcnt(0)" ::: "memory"); \
        if (resc) { const float aq = Al[jq]; \
            _Pragma("unroll") for (int db = 0; db < 8; ++db) o[db] *= aq; } \
        { const bf16x8 pt = *(const __attribute__((address_space(3))) bf16x8*)prd; \
          _Pragma("unroll") for (int db = 0; db < 8; ++db) { const attn2::s16x4 lo = attn2::vtr(vrd + db * 32), hh = attn2::vtr(vrd + db * 32 + 4 * VST); \
              o[db] = __builtin_amdgcn_mfma_f32_16x16x32_bf16((bf16x8){lo[0], lo[1], lo[2], lo[3], hh[0], hh[1], hh[2], hh[3]}, pt, o[db], 0, 0, 0); } } \
        asm volatile("s_waitcnt lgkmcnt(0)" ::: "memory"); \
    } while (0)
    DEC_ISSUE(0, kA, vA); DEC_ISSUE(1, kB, vB);
#pragma unroll 1
    for (int t = 0; t < 4 * NDPG; t += 2) {
        DEC_CONSUME(kA, vA); if (t + 2 < 4 * NDPG) DEC_ISSUE(t + 2, kA, vA); DEC_COMPUTE();
        DEC_CONSUME(kB, vB); if (t + 3 < 4 * NDPG) DEC_ISSUE(t + 3, kB, vB); DEC_COMPUTE();
    }
#undef DEC_ISSUE
#undef DEC_CONSUME
#undef DEC_COMPUTE
#pragma unroll
    for (int m = 0; m < 2; ++m) { lrun[m] += __shfl_xor(lrun[m], 16); lrun[m] += __shfl_xor(lrun[m], 32); }
    float* base = C.DPART + (DUMMY ? (size_t)SB * NDCH * 4160 : 0) + ((((size_t)sb * NDCH + it8 * 2 + th) * 4 + h) * 8) * 130;
    if (jq < 8) {
#pragma unroll
        for (int db = 0; db < 8; ++db) { float* op = base + (size_t)jq * 130 + 2 + db * 16 + 4 * fq; *(f32x2*)op = (f32x2){o[db][0], o[db][1]}; *(f32x2*)(op + 2) = (f32x2){o[db][2], o[db][3]}; } }
#pragma unroll
    for (int m = 0; m < 2; ++m) if (jq < 4 && fq == 0) { float* op = base + (size_t)(m * 4 + jq) * 130; op[0] = mrun[m]; op[1] = lrun[m]; }
}
__device__ __forceinline__ void ocomb_finish(const Ctx& C, int row, float lam, const u32x4 a, const u32x4 b) {
    const int col = C.lane * 8; float o[8];
    o[0] = bflo(a.x) - lam * bflo(b.x); o[1] = bfhi(a.x) - lam * bfhi(b.x); o[2] = bflo(a.y) - lam * bflo(b.y); o[3] = bfhi(a.y) - lam * bfhi(b.y);
    o[4] = bflo(a.z) - lam * bflo(b.z); o[5] = bfhi(a.z) - lam * bfhi(b.z); o[6] = bflo(a.w) - lam * bflo(b.w); o[7] = bfhi(a.w) - lam * bfhi(b.w);
    float ss = 0.f;
#pragma unroll
    for (int j = 0; j < 8; ++j) ss += o[j] * o[j];
    ss += __shfl_xor(ss, 1); ss += __shfl_xor(ss, 2); ss += __shfl_xor(ss, 4); ss += __shfl_xor(ss, 8);
    const float ri = 0.8f * __builtin_amdgcn_rsqf(ss * (1.0f / 128.0f) + EPS); const float* gg = C.subln + (col & 127);
    u32x4 w; w.x = cvt_pk_bf16(o[0] * ri * gg[0], o[1] * ri * gg[1]); w.y = cvt_pk_bf16(o[2] * ri * gg[2], o[3] * ri * gg[3]); w.z = cvt_pk_bf16(o[4] * ri * gg[4], o[5] * ri * gg[5]); w.w = cvt_pk_bf16(o[6] * ri * gg[6], o[7] * ri * gg[7]);
    *(u32x4*)(C.CAT + (size_t)row * 1024 + col) = w;
}
__device__ __forceinline__ void ocomb_rows2(const Ctx& C, int r0, int r1, int rend, float lam) {
    const int col = C.lane * 8; const bool two = r1 < rend;
    const u32x4 a0 = *(const u32x4*)(C.O1 + (size_t)r0 * 512 + col), b0 = *(const u32x4*)(C.O2 + (size_t)r0 * 512 + col);
    u32x4 a1 = a0, b1 = b0; if (two) { a1 = *(const u32x4*)(C.O1 + (size_t)r1 * 512 + col); b1 = *(const u32x4*)(C.O2 + (size_t)r1 * 512 + col); }
    ocomb_finish(C, r0, lam, a0, b0); if (two) ocomb_finish(C, r1, lam, a1, b1);
}
__device__ __forceinline__ void ocomb_sample(const Ctx& C, int item, float lam) {
    const int h = item & 3, rs = item >> 2, sb = rs >> 2, si = rs & 3, lane = C.lane, row = XR0 + NMETA + rs; float o[2][2];
#pragma unroll
    for (int m = 0; m < 2; ++m) {
        const float qd = bf2f(C.QB[(size_t)row * 512 + (h * 2 + m) * 64 + lane]); float sn[4];
#pragma unroll
        for (int t = 0; t < 4; ++t) { float p = qd * C.out[O_KS + (size_t)(sb * 4 + t) * 512 + (h * 2 + m) * 64 + lane]; sn[t] = (t <= si) ? wave_sum(p) : -INFINITY; }
        float mx = fmaxf(fmaxf(sn[0], sn[1]), fmaxf(sn[2], sn[3]));
        const float* pt = C.DPART + ((((size_t)sb * NDCH) * 4 + h) * 8 + m * 4 + si) * 130;
        float pm[NDCH], pl[NDCH], pa0[NDCH], pa1[NDCH];
#pragma unroll
        for (int c = 0; c < NDCH; ++c) { pm[c] = pt[(size_t)c * 4160]; pl[c] = pt[(size_t)c * 4160 + 1]; pa0[c] = pt[(size_t)c * 4160 + 2 + 2 * lane]; pa1[c] = pt[(size_t)c * 4160 + 3 + 2 * lane]; }
#pragma unroll
        for (int c = 0; c < NDCH; ++c) mx = fmaxf(mx, pm[c]);
        float l = 0.f, a0 = 0.f, a1 = 0.f;
#pragma unroll
        for (int c = 0; c < NDCH; ++c) { const float w = exp2f(pm[c] - mx); l += w * pl[c]; a0 += w * pa0[c]; a1 += w * pa1[c]; }
#pragma unroll
        for (int t = 0; t < 4; ++t) { const float w = exp2f(sn[t] - mx); l += w; const float* vr = C.out + O_VS + (size_t)(sb * 4 + t) * 512 + h * 128 + 2 * lane; a0 += w * vr[0]; a1 += w * vr[1]; }
        o[m][0] = a0 / l; o[m][1] = a1 / l; }
    const float d0 = o[0][0] - lam * o[1][0], d1 = o[0][1] - lam * o[1][1]; const float ss = wave_sum(d0 * d0 + d1 * d1);
    const float ri = 0.8f / sqrtf(ss * (1.0f / 128.0f) + EPS);
    *(unsigned*)(C.CAT + (size_t)row * 1024 + h * 128 + 2 * lane) = pk2(d0 * ri * C.subln[2 * lane], d1 * ri * C.subln[2 * lane + 1]);
}
__device__ __forceinline__ f32x4 h1_at(const Ctx& C, int row, int back, int col, const f32x4 g) {
    int rr;
    if (row < NMAIN) { const int b = row >> 13, i = row & (SEQ - 1), pp = NMETA + i - back; rr = pp >= NMETA ? b * SEQ + pp - NMETA : XR0 + pp; }
    else { const int rs = row - XR0 - NMETA, sb = rs >> 2, si = rs & 3, idx = 15 + si - back; if (idx < 15) return *(const f32x4*)(C.st_pool + ((size_t)sb * 15 + idx) * 1024 + col); rr = XR0 + NMETA + sb * 4 + idx - 15; }
    const float rinv = 1.0f / sqrtf(C.rowsq[(size_t)2 * RG + rr] * (1.0f / 1024.0f) + EPS);
    const u32x2 x = *(const u32x2*)(C.XB + (size_t)rr * 1024 + col); return (f32x4){bflo(x.x), bfhi(x.x), bflo(x.y), bfhi(x.y)} * rinv * g;
}
__device__ __forceinline__ void pool_row_g(const Ctx& C, int row, int gi) {
    const bool valid = (row >= XR0 + NMETA && row < RVALID);
    const int col = gi * 256 + C.lane * 4, win = 2 << gi; u32x2* dst = (u32x2*)(C.PA + (size_t)row * 1024 + col);
    if (!valid) { *dst = (u32x2){0u, 0u}; return; }
    const f32x4 g = *(const f32x4*)(C.norm_mix + 1024 + col); const f32x4 cur = h1_at(C, row, 0, col, g); f32x4 s = cur;
#pragma unroll
    for (int j = 1; j < 16; ++j) if (j < win) s += h1_at(C, row, j, col, g);
    const f32x4 q = s * (1.0f / (float)win) - cur; *dst = (u32x2){pk2(q.x, q.y), pk2(q.z, q.w)};
    const int rs = row - XR0 - NMETA, sb = rs >> 2, si = rs & 3; *(f32x4*)(C.out + O_PS + ((size_t)sb * 15 + 11 + si) * 1024 + col) = cur;
    if (si == 0) for (int j = 0; j < 11; ++j) *(f32x4*)(C.out + O_PS + ((size_t)sb * 15 + j) * 1024 + col) = *(const f32x4*)(C.st_pool + ((size_t)sb * 15 + 4 + j) * 1024 + col);
}
__device__ __forceinline__ f32x4 pool_y(const Ctx& C, int b, int p, int col, const f32x4 g) {
    const int rr = p >= NMETA ? b * SEQ + p - NMETA : XR0 + p;
    const float rinv = __builtin_amdgcn_rsqf(C.rowsq[(size_t)2 * RG + rr] * (1.0f / 1024.0f) + EPS);
    const u32x2 x = *(const u32x2*)(C.XB + (size_t)rr * 1024 + col); return (f32x4){bflo(x.x), bfhi(x.x), bflo(x.y), bfhi(x.y)} * rinv * g;
}
__device__ __forceinline__ void pool_strip(const Ctx& C, int item) {
    const int gi = item & 3, strip = (item >> 2) & 255, b = item >> 10, win = 2 << gi, col = gi * 256 + C.lane * 4, p0 = NMETA + strip * 32;
    const f32x4 g = *(const f32x4*)(C.norm_mix + 1024 + col); const float iw = 1.0f / (float)win;
    f32x4 s = (f32x4){0.f, 0.f, 0.f, 0.f};
#pragma unroll
    for (int j = 1; j < 16; ++j) if (j < win) s += pool_y(C, b, p0 - j, col, g);
#pragma unroll 1
    for (int t0 = 0; t0 < 32; t0 += 8) {
        f32x4 y[8], yo[8];
#pragma unroll
        for (int k = 0; k < 8; ++k) { y[k] = pool_y(C, b, p0 + t0 + k, col, g); yo[k] = pool_y(C, b, p0 + t0 + k - win + 1, col, g); }
#pragma unroll
        for (int k = 0; k < 8; ++k) { const int p = p0 + t0 + k; s += y[k]; const f32x4 q = s * iw - y[k]; const int row = b * SEQ + p - NMETA;
            *(u32x2*)(C.PA + (size_t)row * 1024 + col) = (u32x2){pk2(q.x, q.y), pk2(q.z, q.w)}; s -= yo[k];
            const int i = p - NMETA; if (i >= SEQ - 15) *(f32x4*)(C.out + O_PP + ((size_t)b * 15 + (i - (SEQ - 15))) * 1024 + col) = y[k]; }
    }
}
__device__ __forceinline__ void final_row(const Ctx& C, int row) {
    float* o = row < NMAIN ? C.out + O_YP + (size_t)row * 1024 : C.out + O_YS + (size_t)(row - XR0 - NMETA) * 1024;
    const float rinv = __builtin_amdgcn_rsqf(C.rowsq[(size_t)4 * RG + row] * (1.0f / 1024.0f) + EPS);
    const u32x4* xp = (const u32x4*)(C.XB2 + (size_t)row * 1024) + C.lane;
#pragma unroll
    for (int j = 0; j < 2; ++j) { const u32x4 x = xp[64 * j]; const f32x4 g0 = *((const f32x4*)C.norm_final + 128 * j + 2 * C.lane), g1 = *((const f32x4*)C.norm_final + 128 * j + 2 * C.lane + 1);
        *((f32x4*)o + 128 * j + 2 * C.lane) = (f32x4){bflo(x.x), bfhi(x.x), bflo(x.y), bfhi(x.y)} * rinv * g0; *((f32x4*)o + 128 * j + 2 * C.lane + 1) = (f32x4){bflo(x.z), bfhi(x.z), bflo(x.w), bfhi(x.w)} * rinv * g1; }
}
__device__ __forceinline__ void final_rows4(const Ctx& C, int r, int stride) {
    u32x4 x[4][2]; float ri[4];
#pragma unroll
    for (int q = 0; q < 4; ++q) { const int row = r + q * stride; if (row < NMAIN) { const u32x4* xp = (const u32x4*)(C.XB2 + (size_t)row * 1024) + C.lane; x[q][0] = xp[0]; x[q][1] = xp[64];
            ri[q] = __builtin_amdgcn_rsqf(C.rowsq[(size_t)4 * RG + row] * (1.0f / 1024.0f) + EPS); } }
#pragma unroll
    for (int q = 0; q < 4; ++q) { const int row = r + q * stride; if (row < NMAIN) { float* o = C.out + O_YP + (size_t)row * 1024;
#pragma unroll
            for (int j = 0; j < 2; ++j) { const u32x4 v = x[q][j]; const f32x4 g0 = *((const f32x4*)C.norm_final + 128 * j + 2 * C.lane), g1 = *((const f32x4*)C.norm_final + 128 * j + 2 * C.lane + 1);
                *((f32x4*)o + 128 * j + 2 * C.lane) = (f32x4){bflo(v.x), bfhi(v.x), bflo(v.y), bfhi(v.y)} * ri[q] * g0; *((f32x4*)o + 128 * j + 2 * C.lane + 1) = (f32x4){bflo(v.z), bfhi(v.z), bflo(v.w), bfhi(v.w)} * ri[q] * g1; } } }
}
}

#ifndef MK_P3_MULT
#define MK_P3_MULT 1
#endif
#ifndef MK_NDEC
#define MK_NDEC 96
#endif
#ifndef MK_P4_PARTS
#define MK_P4_PARTS 3
#endif
namespace mk {
constexpr int NPH = 14;
struct EpiNull { Ctx C; __device__ __forceinline__ void operator()(const pg8::f32x4 (&acc)[2][2][4][2], const pg8::Unit& u, int wr, int wc, int fr, int fq) const { pg8::f32x4 s = acc[0][0][0][0]; _Pragma("unroll") for (int a = 0; a < 2; ++a) _Pragma("unroll") for (int b = 0; b < 2; ++b) _Pragma("unroll") for (int m = 0; m < 4; ++m) _Pragma("unroll") for (int n = 0; n < 2; ++n) s += acc[a][b][m][n]; if (s[0] + s[1] + s[2] + s[3] == 1.2345e30f) C.rowsq[0] = 1.f; } };
#ifndef MK_ONE_LAUNCH
#define MK_ONE_LAUNCH 1
#endif
__global__ void __launch_bounds__(NTHR, 2) mega_fwd(Args args) {
    extern __shared__ __attribute__((aligned(16))) unsigned char lds[];
    Ctx C; ctx_init(C, args, (LAS unsigned char*)lds);
    for (int u = C.tid; u < (LDS_BYTES - LDSCTL_OFF) / 4; u += NTHR) ((LAS unsigned*)(C.lds + LDSCTL_OFF))[u] = 0u;
    __syncthreads();
    XcdBarrier bar = xcd_barrier_post(C.ctl + CW_BAR, C.MISC + 8);
    const int lo = args.ph_lo, hi = args.ph_hi;
#ifndef MK_PHASE_MASK
#define MK_PHASE_MASK 0x3fff
#endif
#define IN(k) (((MK_PHASE_MASK >> (k)) & 1) && lo <= (k) && (k) < hi)
#define SEAM(k) do { if (IN(k) && IN((k) + 1)) xcd_barrier(bar); } while (0)
#ifndef MK_REPEAT_MASK
#define MK_REPEAT_MASK 0
#endif
#define NREP(k) ((((MK_REPEAT_MASK) >> (k)) & 1) + 1)
#define REPBAR(k) do { if (NREP(k) > 1 && rep + 1 < NREP(k)) xcd_barrier(bar); } while (0)
    const int gw = C.bid * NWAVES + C.wave, NGW = C.G * NWAVES;
    LAS unsigned char* ring = C.lds + RING_OFF;

    if (IN(0)) _Pragma("unroll") for (int rep = 0; rep < NREP(0); ++rep) { p0_prologue(C);  REPBAR(0); } SEAM(0);

    if (IN(1)) _Pragma("unroll") for (int rep = 0; rep < NREP(1); ++rep) {
        EpiProj SE{C}; xgemm<5, 64>(C, C.XB, 1024, C.WIN, 1024, 2048, 1024, 0, SE, ring); __syncthreads();
        pg8::Gemm g{C.XB, C.WIN, 1024, 1024, 1024, 0, 0, 0}; pg8::Order S; S.init(NTILE, 8, 1, C.G, C.bid);
        EpiTile<EpiProj> E{SE};
#if defined(MK_PROBE_F1)
        { pg8::gemm_phase(ring, g, S, E); xcd_barrier(bar); }
#endif
        pg8::gemm_phase(ring, g, S, E);
     REPBAR(1); } SEAM(1);

    if (IN(2)) _Pragma("unroll") for (int rep = 0; rep < NREP(2); ++rep) {
        { pg8::Gemm g{C.A2, C.S5A, 256, 384, 256, 0, (long)1024 * 384, (long)256 * 256}; pg8::Order S; S.init(4, 1, 32, C.G, C.bid); EpiS5a E{C}; pg8::gemm_phase(ring, g, S, E); }
        const int xb0 = C.G > 128 ? 128 : 0;
        { const int nfree = (C.G - xb0) * NWAVES, total = 32 + 128 + 1024;
          for (int w = (C.bid >= xb0 ? (C.bid - xb0) * NWAVES + C.wave : nfree + C.bid * NWAVES + C.wave); w < total; w += C.G * NWAVES) {
              if (w < 32) s5x_item(C, w); else if (w < 160) meta_attn_item(C, w - 32); else s5x_item(C, 32 + (w - 160)); } }
     REPBAR(2); } SEAM(2);

    if (IN(3)) _Pragma("unroll") for (int rep = 0; rep < NREP(3); ++rep) {
        for (int it = gw; it < 64; it += NGW) s5_scan_item(C, it);
        asm volatile("s_waitcnt vmcnt(0)" ::: "memory"); __syncthreads();
        if (C.tid == 0) { if (C.bid * NWAVES < 64) { __builtin_amdgcn_fence(__ATOMIC_RELEASE, "agent"); asm volatile("s_waitcnt vmcnt(0)" ::: "memory"); } __hip_atomic_fetch_add(C.ctl + CW_QUEUE + 448, 1u, RLX_AGENT); }
#ifndef MK_P3_PARTS
#define MK_P3_PARTS 3
#endif
        if ((MK_P3_PARTS & 1) && C.bid < (C.G >= 256 ? MK_NDEC : C.G)) for (;;) {
            if (C.tid == 0) C.MISC[16] = __hip_atomic_fetch_add(C.ctl + CW_QUEUE + 128 * rep, 1u, RLX_AGENT);
            __syncthreads();
            const int idx = (int)C.MISC[16];
            __syncthreads();
            if (idx >= SB * NDIT * MK_P3_MULT) break;
            decode_item<false>(C, idx % (SB * NDIT), ring);
        }
#if defined(MK_DEC_DUMMY)
        if (C.bid < (C.G >= 256 ? MK_NDEC : C.G)) for (;;) {
            if (C.tid == 0) C.MISC[16] = __hip_atomic_fetch_add(C.ctl + CW_QUEUE + 256, 1u, RLX_AGENT);
            __syncthreads();
            const int idx = (int)C.MISC[16];
            __syncthreads();
            if (idx >= 256) break;
            decode_item<true>(C, idx, ring);
        }
#endif
        if (MK_P3_PARTS & 2) for (;;) {
#if defined(MK_XCD_QUEUES)
            const int xq = C.bid & 7;
            if (C.tid == 0) C.MISC[16] = __hip_atomic_fetch_add(C.ctl + CW_QUEUE + 512 + 64 * xq + 1024 * rep, 1u, RLX_AGENT);
            __syncthreads();
            const int a = (int)C.MISC[16];
            __syncthreads();
            if (a >= 64 * MK_P3_MULT) break;
            const int qb = 31 - ((a & 63) >> 1), st = 2 * xq + (a & 1), b = st >> 3, hq = st & 7;
#else
            if (C.tid == 0) C.MISC[16] = __hip_atomic_fetch_add(C.ctl + CW_QUEUE + 64 + 128 * rep, 1u, RLX_AGENT);
            __syncthreads();
            const int a = (int)C.MISC[16];
            __syncthreads();
            if (a >= 512 * MK_P3_MULT) break;
            const int qb = 31 - ((a & 511) >> 4), b = (a >> 3) & 1, hq = a & 7;
#endif
            attn2::attn_unit<8>(b, hq, qb, (const attn2::bf16*)C.QB, (const attn2::bf16*)C.KB, (const attn2::bf16*)C.VB, (attn2::bf16*)C.O1, (attn2::bf16*)C.O2, (char*)lds + RING_OFF);
        }
        { bool acq = false;
          for (;;) {
            if (C.tid == 0) C.MISC[16] = __hip_atomic_fetch_add(C.ctl + CW_QUEUE + 384, 1u, RLX_AGENT);
            __syncthreads();
            const int idx = (int)C.MISC[16];
            __syncthreads();
            if (idx >= 128) break;
            if (!acq) { acq = true;
                if (C.wave == 0) { unsigned sp = 0; while (__hip_atomic_load(C.ctl + CW_QUEUE + 448, RLX_AGENT) < (unsigned)C.G && ++sp < (1u << 22)) __builtin_amdgcn_s_sleep(2);
                    __builtin_amdgcn_fence(__ATOMIC_ACQUIRE, "agent"); }
                asm volatile("s_waitcnt vmcnt(0)" ::: "memory"); __syncthreads(); }
            pg8::Gemm g{C.A2, C.S5C, 384, 384, 384, 0, (long)1024 * 384, (long)256 * 384}; pg8::Order S; S.init(4, 1, 32, 128, idx); EpiS5c E{C}; pg8::gemm_phase(ring, g, S, E);
          } }
        for (;;) {
            if (C.tid == 0) C.MISC[16] = __hip_atomic_fetch_add(C.ctl + CW_QUEUE + 320, 1u, RLX_AGENT);
            __syncthreads();
            const int base = (int)C.MISC[16] * NWAVES;
            __syncthreads();
            if (base >= N_LATE_A) break;
            late_weight_item(C, base + C.wave, (LAS float*)(ring + C.wave * 16384));
        }
     REPBAR(3); } SEAM(3);

    if (IN(4)) _Pragma("unroll") for (int rep = 0; rep < NREP(4); ++rep) {
        const int xb0 = C.G > 128 ? 128 : 0;
        const float lam = lam_full(C);
        if (xb0 == 0 || C.bid < xb0) { const int w0 = gw, nw = (xb0 ? xb0 : C.G) * NWAVES;
            for (int r = w0; r < XR0 + NMETA; r += 2 * nw) ocomb_rows2(C, r, r + nw, XR0 + NMETA, lam);
            for (int it = w0; it < NSAMP * 4; it += nw) ocomb_sample(C, it, lam); }
        __syncthreads();
        { EpiGlu SE{C}; xgemm<2, 64>(C, C.YS, 512, C.WGLU, 512, 512, 512, 0, SE, ring); __syncthreads();
          pg8::Gemm g{C.YS, C.WGLU, 512, 512, 512, 0, 0, 0}; pg8::Order S; const int ng = C.G - xb0;
          if (C.bid >= xb0) { S.init(NTILE, 2, 1, ng, C.bid - xb0); EpiTile<EpiGlu> E{SE}; pg8::gemm_phase(ring, g, S, E); }
          if (xb0 == 0 || C.bid < xb0) for (;;) {
              if (C.tid == 0) C.MISC[16] = __hip_atomic_fetch_add(C.ctl + CW_QUEUE + 704, 1u, RLX_AGENT);
              __syncthreads();
              const int base = N_LATE_A + (int)C.MISC[16] * NWAVES;
              __syncthreads();
              if (base >= N_LATE_B) break;
              late_weight_item(C, base + C.wave, (LAS float*)(ring + C.wave * 16384));
          } }
     REPBAR(4); } SEAM(4);

    if (IN(6)) _Pragma("unroll") for (int rep = 0; rep < NREP(6); ++rep) {
        EpiResid<0> SE{C, 1, C.XB, C.XB}; xgemm<2, 64>(C, C.CAT, 1024, C.WO, 1024, 1024, 1024, 0, SE, ring); __syncthreads();
        pg8::Gemm g{C.CAT, C.WO, 1024, 1024, 1024, 0, 0, 0}; pg8::Order S; S.init(NTILE, 4, 1, C.G, C.bid); EpiTile<EpiResid<0>> E{SE};
#if defined(MK_PROBE_F6)
        { EpiResid<0> SD{C, 7, C.PA, C.XB}; xgemm<2, 64>(C, C.CAT, 1024, C.WO, 1024, 1024, 1024, 0, SD, ring); __syncthreads(); EpiTile<EpiResid<0>> ED{SD}; pg8::gemm_phase(ring, g, S, ED); xcd_barrier(bar); }
#endif
        pg8::gemm_phase(ring, g, S, E);
     REPBAR(6); } SEAM(6);

    if (IN(7)) _Pragma("unroll") for (int rep = 0; rep < NREP(7); ++rep) { EpiUp SE{C, 1};
#if defined(MK_PROBE_X7)
        xgemm<5, 64>(C, C.XB, 1024, C.WUP0, 1024, 4096, 1024, 0, SE, ring); __syncthreads(); xgemm<5, 64>(C, C.XB, 1024, C.WUP0, 1024, 4096, 1024, 0, SE, ring); __syncthreads(); xgemm<5, 64>(C, C.XB, 1024, C.WUP0, 1024, 4096, 1024, 0, SE, ring); __syncthreads();
#endif
        xgemm<5, 64>(C, C.XB, 1024, C.WUP0, 1024, 4096, 1024, 0, SE, ring); __syncthreads();
        pg8::Gemm g{C.XB, C.WUP0, 1024, 1024, 1024, 0, 0, 0}; pg8::Order S; S.init(NTILE, 16, 1, C.G, C.bid); EpiTile<EpiUp> E{SE};
#if defined(MK_PROBE_NOEPI)
        if (rep == 1) { EpiNull EN{C}; pg8::gemm_phase(ring, g, S, EN); } else
#endif
        pg8::gemm_phase(ring, g, S, E);  REPBAR(7); } SEAM(7);
    if (IN(8)) _Pragma("unroll") for (int rep = 0; rep < NREP(8); ++rep) { EpiResid<1> SE{C, 2, C.XB, C.XB}; xgemm<2, 64>(C, C.HB, 4096, C.WDN0, 4096, 1024, 4096, 0, SE, ring); __syncthreads();
        if (C.G <= 160 || C.bid >= 160) for (;;) {
            if (C.tid == 0) C.MISC[16] = __hip_atomic_fetch_add(C.ctl + CW_QUEUE + 768, 1u, RLX_AGENT);
            __syncthreads();
            const int base = N_LATE_B + (int)C.MISC[16] * NWAVES;
            __syncthreads();
            if (base >= N_LATE) break;
            if (base + C.wave < N_LATE) late_weight_item(C, base + C.wave, (LAS float*)(ring + C.wave * 16384));
        }
        __syncthreads();
        pg8::Gemm g{C.HB, C.WDN0, 4096, 4096, 4096, 0, 0, 0}; pg8::Order S; S.init(NTILE, 4, 1, C.G, C.bid); EpiTile<EpiResid<1>> E{SE};
#if defined(MK_PROBE_K8)
        { EpiNull EN{C}; pg8::gemm_phase(ring, g, S, EN); __syncthreads(); }
#endif
#if defined(MK_PROBE_F8)
        { EpiResid<1> SD{C, 7, C.PA, C.XB}; xgemm<2, 64>(C, C.HB, 4096, C.WDN0, 4096, 1024, 4096, 0, SD, ring); __syncthreads(); EpiTile<EpiResid<1>> ED{SD}; pg8::gemm_phase(ring, g, S, ED); xcd_barrier(bar); }
#endif
        pg8::gemm_phase(ring, g, S, E);  REPBAR(8); } SEAM(8);

    if (IN(10)) _Pragma("unroll") for (int rep = 0; rep < NREP(10); ++rep) {
        EpiResid<2> SE{C, 3, C.XB2, C.XB};
#if defined(MK_PROBE_P10A)
        for (int u = C.bid; u < 32 * 5; u += C.G) { const int cg = u & 31, rc = u >> 5; for (int rr = C.wave; rr < 32; rr += NWAVES) pool_row_g(C, XR0 + rc * 32 + rr, cg >> 3); }
        xcd_barrier(bar);
#endif
        for (int u = C.bid; u < 32 * 5; u += C.G) { const int cg = u & 31, rc = u >> 5; for (int rr = C.wave; rr < 32; rr += NWAVES) pool_row_g(C, XR0 + rc * 32 + rr, cg >> 3); }
        asm volatile("s_waitcnt vmcnt(0)" ::: "memory"); __syncthreads();
        xgemm<2, 32>(C, C.PA, 1024, C.POOLT, 256, 1024, 256, 256, SE, ring); __syncthreads();
        pg8::Gemm g{C.PA, C.POOLT, 256, 1024, 256, 256, 0, 0}; pg8::Order S; S.init(NTILE, 4, 1, C.G, C.bid);
#if defined(MK_PROBE_P10B)
        { pg8::Unit u; for (int i = 0; S.next(i, u); ++i) pool_strip(C, ((u.pm >> 5) << 10) | ((((u.pm & 31) << 3) | C.wave) << 2) | u.pn); }
        xcd_barrier(bar);
#endif
        { pg8::Unit u; for (int i = 0; S.next(i, u); ++i) pool_strip(C, ((u.pm >> 5) << 10) | ((((u.pm & 31) << 3) | C.wave) << 2) | u.pn); }
        asm volatile("s_waitcnt vmcnt(0)" ::: "memory"); __syncthreads();
        EpiTile<EpiResid<2>> E{SE}; pg8::gemm_phase(ring, g, S, E);
         REPBAR(10); } SEAM(10);

    if (IN(11)) _Pragma("unroll") for (int rep = 0; rep < NREP(11); ++rep) { EpiUp SE{C, 3}; xgemm<5, 64>(C, C.XB2, 1024, C.WUP1, 1024, 4096, 1024, 0, SE, ring); __syncthreads();
        pg8::Gemm g{C.XB2, C.WUP1, 1024, 1024, 1024, 0, 0, 0}; pg8::Order S; S.init(NTILE, 16, 1, C.G, C.bid); EpiTile<EpiUp> E{SE}; pg8::gemm_phase(ring, g, S, E);  REPBAR(11); } SEAM(11);
    if (IN(12)) { EpiResid<3> SE{C, 4, C.XB2, C.XB2}; xgemm<2, 64>(C, C.HB, 4096, C.WDN1, 4096, 1024, 4096, 0, SE, ring);
        asm volatile("s_waitcnt vmcnt(0)" ::: "memory"); __syncthreads();
        if (C.tid == 0) { if (C.bid < 160) { __builtin_amdgcn_fence(__ATOMIC_RELEASE, "agent"); asm volatile("s_waitcnt vmcnt(0)" ::: "memory"); } __hip_atomic_fetch_add(C.ctl + CW_FINX, 1u, RLX_AGENT); }
        pg8::Gemm g{C.HB, C.WDN1, 4096, 4096, 4096, 0, 0, 0}; pg8::Order S; S.init(NTILE, 4, 1, C.G, C.bid); EpiFinal E{C, C.ctl + CW_FIN}; pg8::gemm_phase(ring, g, S, E);
        if (XR0 + NMETA + C.bid * NWAVES < RVALID) {
            if (C.wave == 0) { unsigned sp = 0; while (__hip_atomic_load(C.ctl + CW_FINX, RLX_AGENT) < (unsigned)C.G && ++sp < (1u << 22)) __builtin_amdgcn_s_sleep(2);
                __builtin_amdgcn_fence(__ATOMIC_ACQUIRE, "agent"); }
            asm volatile("s_waitcnt vmcnt(0)" ::: "memory"); __syncthreads();
            for (int r = XR0 + NMETA + gw; r < RVALID; r += NGW) final_row(C, r); } }
#undef IN
#undef SEAM
}
}

#ifndef MK_CHECK
#define MK_CHECK 0
#endif
extern "C" void kernel_launch(void* const* d_in, const int* in_sizes, int n_in, void* d_out, int out_size, void* d_ws, size_t ws_size, hipStream_t stream) {
    using namespace mk;
    static int grid = 0;
    if (grid == 0) {
        if (n_in != 34 || (size_t)out_size != O_END || ws_size < WS_END) { fprintf(stderr, "kernel_launch: unexpected sizes n_in %d out %d ws %zu\n", n_in, out_size, ws_size); grid = -1; return; }
        int dev = 0, cus = 0, per_cu = 0;
        if (hipGetDevice(&dev) != hipSuccess || hipDeviceGetAttribute(&cus, hipDeviceAttributeMultiprocessorCount, dev) != hipSuccess) { grid = -1; return; }
        if (hipFuncSetAttribute((const void*)mega_fwd, hipFuncAttributeMaxDynamicSharedMemorySize, LDS_BYTES) != hipSuccess) { fprintf(stderr, "kernel_launch: hipFuncSetAttribute failed\n"); grid = -1; return; }
        if (hipOccupancyMaxActiveBlocksPerMultiprocessor(&per_cu, (const void*)mega_fwd, NTHR, LDS_BYTES) != hipSuccess || per_cu < 1) fprintf(stderr, "kernel_launch: occupancy query says %d\n", per_cu);
        (void)hipGetLastError();
        grid = cus;
    }
    if (grid < 0) return;
    (void)hipMemsetAsync((char*)d_ws + WS_CTL, 0, CTL_ZERO_BYTES, stream);
    Args a{};
    for (int i = 0; i < 34; ++i) a.in[i] = (const float*)d_in[i];
    a.out = (float*)d_out; a.ws = (unsigned char*)d_ws;
#if MK_CHECK
    check_run(a, d_in, (float*)d_out, (unsigned char*)d_ws, ws_size, grid, stream);
#else
#if MK_ONE_LAUNCH
    a.ph_lo = 0; a.ph_hi = NPH;
    hipLaunchKernelGGL(mega_fwd, dim3(grid), dim3(NTHR), LDS_BYTES, stream, a);
#else
    for (int k = 0; k < NPH; ++k) { a.ph_lo = k; a.ph_hi = k + 1; hipLaunchKernelGGL(mega_fwd, dim3(grid), dim3(NTHR), LDS_BYTES, stream, a); }
#endif
#endif
}
```

```cpp
#include <hip/hip_runtime.h>
#include <cstdio>
#include <cstdint>
#define MK_CHECK 0
#define MK_ONE_LAUNCH 1
#define MK_NDEC 96

namespace pg8 {
#define PG8_LAS __attribute__((address_space(3)))
typedef unsigned short bf16_t;
typedef short bf16x8 __attribute__((ext_vector_type(8)));
typedef float f32x4 __attribute__((ext_vector_type(4)));
typedef unsigned u32x4 __attribute__((ext_vector_type(4)));
constexpr int BM = 256, BK = 64, HALF = 128, HTB = HALF * BK * 2, STAGE_BYTES = 8 * HTB, NXCD = 8, WGM = 8;
__host__ __device__ __forceinline__ int lds_byte(int r, int c) { const int st = (r >> 4) * 2 + (c >> 5), rr = r & 15, cc = c & 31, ob = rr * 64 + cc * 2; return st * 1024 + (ob ^ (((ob >> 9) & 1) << 5)); }
__host__ __device__ __forceinline__ void stage_rc(int b, int& R, int& C) { const int st = b / 1024, sb = b % 1024, swz = sb ^ (((sb >> 9) & 1) << 5); R = (st >> 1) * 16 + swz / 64; C = (st & 1) * 32 + (swz % 64) / 2; }
__host__ __device__ __forceinline__ int perm32(int rho) { const int n = rho >> 4, i = rho & 15; return 8 * (i >> 2) + 4 * n + (i & 3); }

struct Unit { int pm, pn, pb; };
struct Gemm { const bf16_t* A; const bf16_t* Bt; int K, lda, ldb; long a_pn, a_pb, b_pb; };
struct Order {
    int nM, nN, nB, nwg, G, c;
    __device__ __forceinline__ void init(int nM_, int nN_, int nB_, int G_, int c_) { nM = nM_; nN = nN_; nB = nB_; nwg = nM * nN * nB; G = G_; c = c_; }
    __device__ __forceinline__ bool next(int i, Unit& u) const {
        const long L = (long)i * G + c; if (L >= nwg) return false;
        if (nB > 1) { const int per = nM * nN, r = (int)(L % per); u.pb = (int)(L / per); u.pm = r % nM; u.pn = r / nM; return true; }
        int wgid = (int)L; { const int q = nwg / NXCD, r = nwg % NXCD, xcd = wgid % NXCD, off = wgid / NXCD; wgid = (xcd < r ? xcd * (q + 1) : r * (q + 1) + (xcd - r) * q) + off; }
        const int nig = WGM * nN, gid = wgid / nig, fm = gid * WGM, gsz = (nM - fm) < WGM ? (nM - fm) : WGM;
        u.pm = fm + ((wgid % nig) % gsz); u.pn = (wgid % nig) / gsz; u.pb = 0; return true;
    }
};
__device__ __forceinline__ unsigned cvt_pk_bf16(float lo, float hi) { unsigned r; asm volatile("v_cvt_pk_bf16_f32 %0, %1, %2" : "=v"(r) : "v"(lo), "v"(hi)); return r; }

template <class Epi>
__device__ __forceinline__ void gemm_phase(PG8_LAS unsigned char* lds, const Gemm g, const Order& S, const Epi& E) {
    const int tid = threadIdx.x, wid = __builtin_amdgcn_readfirstlane(tid >> 6), lane = tid & 63, wr = wid >> 2, wc = wid & 3, fr = lane & 15, fq = lane >> 4;
    const int K = g.K, nt = K / BK;
    unsigned voffA[2], voffB[2];
#pragma unroll
    for (int i = 0; i < 2; ++i) { int R, C; stage_rc(tid * 16 + i * 8192, R, C); const int Rb = (R & ~31) + perm32(R & 31);
        voffA[i] = (unsigned)(R * g.lda + C) * 2u; voffB[i] = (unsigned)(Rb * g.ldb + C) * 2u; }
    const size_t kstep = (size_t)(BK * 2);
    const size_t hstepA = (size_t)HALF * g.lda * 2, hstepB = (size_t)HALF * g.ldb * 2;
    const unsigned ldsw = (unsigned)wid * 1024u;
    const int aoff = lds_byte(wr * 64 + fr, fq * 8), boff = lds_byte(wc * 32 + fr, fq * 8);
#define PG8_APTR(u) ((const char*)g.A + ((size_t)(u).pb * g.a_pb + (size_t)(u).pn * g.a_pn + (size_t)(u).pm * BM * g.lda) * 2)
#define PG8_BPTR(u) ((const char*)g.Bt + ((size_t)(u).pb * g.b_pb + (size_t)(u).pn * BM * g.ldb) * 2)
#define PG8_SA(b, h) (((b) * 2 + (h)) * HTB)
#define PG8_SB(b, h) ((4 + (b) * 2 + (h)) * HTB)
#define PG8_STAGE(bufoff, gbase, voff) do { _Pragma("unroll") for (int _i = 0; _i < 2; ++_i) \
        __builtin_amdgcn_global_load_lds((const unsigned*)((const char*)(gbase) + (voff)[_i]), (PG8_LAS unsigned*)(lds + (bufoff) + ldsw + _i * 8192), 16, 0, 0); } while (0)
#define PG8_LDA(dst, b, h) do { _Pragma("unroll") for (int m = 0; m < 4; ++m) _Pragma("unroll") for (int k = 0; k < 2; ++k) dst[m][k] = *(const PG8_LAS bf16x8*)(lds + PG8_SA(b, h) + aoff + m * 2048 + k * 1024); } while (0)
#define PG8_LDB(dst, b, h) do { _Pragma("unroll") for (int n = 0; n < 2; ++n) _Pragma("unroll") for (int k = 0; k < 2; ++k) dst[n][k] = *(const PG8_LAS bf16x8*)(lds + PG8_SB(b, h) + boff + n * 2048 + k * 1024); } while (0)
#define PG8_MMA(ai, bj, At, Bt) do { __builtin_amdgcn_s_setprio(1); _Pragma("unroll") for (int m = 0; m < 4; ++m) _Pragma("unroll") for (int n = 0; n < 2; ++n) _Pragma("unroll") for (int k = 0; k < 2; ++k) \
        acc[ai][bj][m][n] = __builtin_amdgcn_mfma_f32_16x16x32_bf16(Bt[n][k], At[m][k], acc[ai][bj][m][n], 0, 0, 0); __builtin_amdgcn_s_setprio(0); } while (0)
#define PG8_WAIT_V(n) asm volatile("s_waitcnt vmcnt(" #n ")" ::: "memory")
#define PG8_WAIT_L(n) asm volatile("s_waitcnt lgkmcnt(" #n ")" ::: "memory")
#define PG8_BAR __builtin_amdgcn_s_barrier()
#define PG8_SCHED __builtin_amdgcn_sched_barrier(0)
    Unit cur, nxt; int ui = 0;
    if (!S.next(0, cur)) return;
    f32x4 acc[2][2][4][2];
#pragma unroll
    for (int a = 0; a < 2; ++a)
#pragma unroll
        for (int b = 0; b < 2; ++b)
#pragma unroll
            for (int m = 0; m < 4; ++m)
#pragma unroll
                for (int n = 0; n < 2; ++n) acc[a][b][m][n] = (f32x4){0.f, 0.f, 0.f, 0.f};
    bf16x8 At[4][2], B0[2][2], B1[2][2];
    const char* cA = PG8_APTR(cur); const char* cB = PG8_BPTR(cur);
    PG8_STAGE(PG8_SB(0, 0), cB, voffB); PG8_STAGE(PG8_SB(0, 1), cB + hstepB, voffB); PG8_STAGE(PG8_SA(0, 0), cA, voffA); PG8_STAGE(PG8_SA(0, 1), cA + hstepA, voffA);
    if (wr == 1) PG8_BAR;
    PG8_WAIT_V(2); PG8_BAR;
    PG8_STAGE(PG8_SB(1, 0), cB + kstep, voffB); PG8_STAGE(PG8_SA(1, 0), cA + kstep, voffA); PG8_STAGE(PG8_SB(1, 1), cB + hstepB + kstep, voffB);
    PG8_WAIT_V(6); PG8_BAR;
    for (;;) {
        const bool has_next = S.next(ui + 1, nxt);
        const char* nA = has_next ? PG8_APTR(nxt) : cA; const char* nB = has_next ? PG8_BPTR(nxt) : cB;
#pragma unroll 1
        for (int t = 0; t < nt; t += 2) {
            const bool last = (t == nt - 2);
            const char* a1 = cA + (size_t)(t + 1) * kstep;
            const char* a2 = last ? nA : cA + (size_t)(t + 2) * kstep; const char* b2 = last ? nB : cB + (size_t)(t + 2) * kstep;
            const char* a3 = a2 + kstep; const char* b3 = b2 + kstep;
            PG8_LDB(B0, 0, 0); PG8_LDB(B1, 0, 1); PG8_SCHED; PG8_LDA(At, 0, 0); PG8_STAGE(PG8_SA(1, 1), a1 + hstepA, voffA);
            PG8_WAIT_V(8); PG8_WAIT_L(0); PG8_BAR; PG8_MMA(0, 0, At, B0); PG8_MMA(0, 1, At, B1); PG8_BAR; PG8_SCHED;
            PG8_LDA(At, 0, 1); PG8_STAGE(PG8_SB(0, 0), b2, voffB); PG8_STAGE(PG8_SB(0, 1), b2 + hstepB, voffB); PG8_STAGE(PG8_SA(0, 0), a2, voffA);
            PG8_WAIT_V(8); PG8_WAIT_L(0); PG8_BAR; PG8_MMA(1, 0, At, B0); PG8_MMA(1, 1, At, B1); PG8_BAR; PG8_SCHED;
            PG8_LDB(B0, 1, 0); PG8_LDB(B1, 1, 1); PG8_SCHED; PG8_LDA(At, 1, 0); PG8_STAGE(PG8_SA(0, 1), a2 + hstepA, voffA);
            PG8_WAIT_V(8); PG8_WAIT_L(0); PG8_BAR; PG8_MMA(0, 0, At, B0); PG8_MMA(0, 1, At, B1); PG8_BAR; PG8_SCHED;
            PG8_LDA(At, 1, 1); PG8_STAGE(PG8_SB(1, 0), b3, voffB); PG8_STAGE(PG8_SB(1, 1), b3 + hstepB, voffB); PG8_STAGE(PG8_SA(1, 0), a3, voffA);
            PG8_WAIT_V(8); PG8_WAIT_L(0); PG8_BAR; PG8_MMA(1, 0, At, B0); PG8_MMA(1, 1, At, B1); PG8_BAR; PG8_SCHED;
        }
        if (wr == 0) PG8_BAR;
        E(acc, cur, wr, wc, fr, fq);
        if (!has_next) break;
#pragma unroll
        for (int a = 0; a < 2; ++a)
#pragma unroll
            for (int b = 0; b < 2; ++b)
#pragma unroll
                for (int m = 0; m < 4; ++m)
#pragma unroll
                    for (int n = 0; n < 2; ++n) acc[a][b][m][n] = (f32x4){0.f, 0.f, 0.f, 0.f};
        cur = nxt; cA = nA; cB = nB; ++ui;
        if (wr == 1) PG8_BAR;
    }
    PG8_WAIT_V(0);
    PG8_BAR;
#undef PG8_APTR
#undef PG8_BPTR
#undef PG8_SA
#undef PG8_SB
#undef PG8_STAGE
#undef PG8_LDA
#undef PG8_LDB
#undef PG8_MMA
#undef PG8_WAIT_V
#undef PG8_WAIT_L
#undef PG8_BAR
#undef PG8_SCHED
}
}

#include <hip/hip_bf16.h>
namespace attn2 {
using bf16=__hip_bfloat16;
using bf16x8=__attribute__((ext_vector_type(8)))short;
using s16x4=__attribute__((ext_vector_type(4)))short;
using f32x16=__attribute__((ext_vector_type(16)))float;
using u32x4=__attribute__((ext_vector_type(4)))unsigned;
constexpr int D=64,DM=512,QROWS=8192,KROWS=8256;
constexpr int NW=8,QBLK=32,QB=QBLK*NW,KVBLK=64,NQB=QROWS/QB;
__device__ __forceinline__ int crow(int r,int hi){return (r&3)+8*(r>>2)+4*hi;}
#define SBAR() __builtin_amdgcn_sched_barrier(0)
__device__ __forceinline__ void cmask(f32x16&p0,f32x16&p1,int jb,int qrel,int hi){
  const float NEG=-INFINITY; int kb=64*jb+4*hi;
  #pragma unroll
  for(int r=0;r<16;++r){int kv=kb+(r&3)+8*(r>>2); if(kv>qrel)p0[r]=NEG; if(kv+32>qrel)p1[r]=NEG;}
}

constexpr int NSLOT=3, SLOTB=8192;
constexpr int LDS_K=0, LDS_V=NSLOT*SLOTB, LDS_WS=LDS_V+NSLOT*2*SLOTB, LDS_OST=LDS_WS+NW*64*4, LDS_BYTES=LDS_OST+NW*4096;
constexpr float C2=0.125f*1.4426950408889634f;
__device__ __forceinline__ void glds16(const void*gsrc,unsigned lds_dst){unsigned keep;
  asm volatile("s_mov_b32 %0, m0\n\ts_mov_b32 m0, %2\n\ts_nop 0\n\tglobal_load_lds_dwordx4 %1, off\n\ts_mov_b32 m0, %0":"=&s"(keep):"v"(gsrc),"s"(lds_dst):"memory");}
__device__ __forceinline__ float max3f(float a,float b,float c){float r;asm("v_max3_f32 %0, %1, %2, %3":"=v"(r):"v"(a),"v"(b),"v"(c));return r;}
__device__ __forceinline__ float max2f(float a,float b){float r;asm("v_max_f32_e32 %0, %1, %2":"=v"(r):"v"(a),"v"(b));return r;}
__device__ __forceinline__ float fadd_s(float a,float b){float r;asm("v_add_f32_e32 %0, %1, %2":"=v"(r):"v"(a),"v"(b));return r;}
__device__ __forceinline__ float fsub_s(float a,float b){float r;asm("v_sub_f32_e32 %0, %1, %2":"=v"(r):"v"(a),"v"(b));return r;}
typedef float f32x2_t __attribute__((ext_vector_type(2))); typedef __bf16 bf16x2_t __attribute__((ext_vector_type(2)));
__device__ __forceinline__ unsigned cvtpk_s(float lo,float hi){f32x2_t v={lo,hi};bf16x2_t b=__builtin_convertvector(v,bf16x2_t);return __builtin_bit_cast(unsigned,b);}
#define WAIT_BAR(N) asm volatile("s_waitcnt vmcnt(" #N ") lgkmcnt(0)\n\ts_barrier":::"memory")

__device__ __forceinline__ void qkt(f32x16&p0,f32x16&p1,const char*Kslot,const bf16x8*qr,const f32x16&negm,int r32,int hi){
  const char*kb=Kslot+hi*1024+r32*16;
  #pragma unroll
  for(int d0=0;d0<4;++d0){
    const bf16x8 b0=*reinterpret_cast<const bf16x8*>(kb+d0*2048);
    const bf16x8 b1=*reinterpret_cast<const bf16x8*>(kb+d0*2048+512);
    if(d0==0){p0=__builtin_amdgcn_mfma_f32_32x32x16_bf16(b0,qr[0],negm,0,0,0);p1=__builtin_amdgcn_mfma_f32_32x32x16_bf16(b1,qr[0],negm,0,0,0);}
    else{p0=__builtin_amdgcn_mfma_f32_32x32x16_bf16(b0,qr[d0],p0,0,0,0);p1=__builtin_amdgcn_mfma_f32_32x32x16_bf16(b1,qr[d0],p1,0,0,0);}}
}
typedef __attribute__((address_space(3))) const char* lds_cptr;
typedef short v4i16_t __attribute__((ext_vector_type(4)));
__device__ __forceinline__ void kload8(bf16x8*kf,lds_cptr kp){
  kf[0]=*(const __attribute__((address_space(3))) bf16x8*)(kp);      kf[1]=*(const __attribute__((address_space(3))) bf16x8*)(kp+512);
  kf[2]=*(const __attribute__((address_space(3))) bf16x8*)(kp+2048); kf[3]=*(const __attribute__((address_space(3))) bf16x8*)(kp+2560);
  kf[4]=*(const __attribute__((address_space(3))) bf16x8*)(kp+4096); kf[5]=*(const __attribute__((address_space(3))) bf16x8*)(kp+4608);
  kf[6]=*(const __attribute__((address_space(3))) bf16x8*)(kp+6144); kf[7]=*(const __attribute__((address_space(3))) bf16x8*)(kp+6656);
}
__device__ __forceinline__ void kload2(bf16x8*kf,lds_cptr kp,int j){ kf[2*j]=*(const __attribute__((address_space(3))) bf16x8*)(kp+j*2048); kf[2*j+1]=*(const __attribute__((address_space(3))) bf16x8*)(kp+j*2048+512); }
__device__ __forceinline__ s16x4 vtr(lds_cptr p){ return __builtin_bit_cast(s16x4,__builtin_amdgcn_ds_read_tr16_b64_v4i16((__attribute__((address_space(3))) v4i16_t*)p)); }
__device__ __forceinline__ float rowmax(const f32x16&p0,const f32x16&p1){
  float a=max3f(p0[0],p0[1],p1[0]),b=max3f(p0[2],p0[3],p1[1]);a=max3f(a,p1[2],p1[3]);
  #pragma unroll
  for(int r=4;r<16;r+=4){a=max3f(a,p0[r],p0[r+1]);b=max3f(b,p0[r+2],p0[r+3]);a=max3f(a,p1[r],p1[r+1]);b=max3f(b,p1[r+2],p1[r+3]);}
  const float m=max2f(a,b);
  auto rr=__builtin_amdgcn_permlane32_swap(__float_as_uint(m),__float_as_uint(m),false,false);
  return max2f(__uint_as_float(rr[0]),__uint_as_float(rr[1]));
}
__device__ __forceinline__ void pv(f32x16*o,int vb,bf16x8 pa0,bf16x8 pa1,bf16x8 pa2,bf16x8 pa3){
  #pragma unroll
  for(int d0=0;d0<4;++d0){s16x4 lo[4],hi[4];
    #pragma unroll
    for(int ks=0;ks<4;++ks){
      asm volatile("ds_read_b64_tr_b16 %0,%1 offset:%c2":"=&v"(lo[ks]):"v"(vb),"i"(d0*4096+ks*1024):"memory");
      asm volatile("ds_read_b64_tr_b16 %0,%1 offset:%c2":"=&v"(hi[ks]):"v"(vb),"i"(d0*4096+ks*1024+512):"memory");}
    asm volatile("s_waitcnt lgkmcnt(0)":::"memory");SBAR();
    #define PK(k) (bf16x8){lo[k][0],lo[k][1],lo[k][2],lo[k][3],hi[k][0],hi[k][1],hi[k][2],hi[k][3]}
    o[d0]=__builtin_amdgcn_mfma_f32_32x32x16_bf16(pa0,PK(0),o[d0],0,0,0);
    o[d0]=__builtin_amdgcn_mfma_f32_32x32x16_bf16(pa1,PK(1),o[d0],0,0,0);
    o[d0]=__builtin_amdgcn_mfma_f32_32x32x16_bf16(pa2,PK(2),o[d0],0,0,0);
    o[d0]=__builtin_amdgcn_mfma_f32_32x32x16_bf16(pa3,PK(3),o[d0],0,0,0);
    #undef PK
  }
}

#ifndef ATTN_STORE16
#define ATTN_STORE16(p,v) (*(u32x4*)(p)=(v))
#endif
template<int THRL> __device__ __forceinline__ void attn_unit(int b,int hq,int qb,const bf16*Q,const bf16*__restrict__ K,const bf16*__restrict__ V,bf16*O1,bf16*O2,char*shm){
  const int tid=threadIdx.x,lane=tid&63,r32=lane&31,hi=lane>>5; const int wid=__builtin_amdgcn_readfirstlane(tid>>6);
  const long rowbase=(long)b*QROWS; const int q0=qb*QB; const int head=hq>>1;
  const bf16*Qw=Q+(rowbase+q0+wid*QBLK)*DM+hq*D;
  const bf16*Kh=K+(long)b*KROWS*DM+hq*D,*Vh=V+(long)b*KROWS*DM+head*128;
  const unsigned lds0=(unsigned)(uintptr_t)shm;
  float*wsf=(float*)(shm+LDS_WS)+wid*64;
  const bf16*ksrc=Kh+(long)lane*DM+wid*8;
  const bf16*vsrc=Vh+(long)(16*(wid&3)+(lane>>2))*DM+(wid>>2)*32+(lane&3)*8;
  const unsigned kdst=lds0+LDS_K+wid*1024, vdst=lds0+LDS_V+wid*1024;
  #define DMA_K(t,slot) glds16(ksrc+(long)(t)*KVBLK*DM,(unsigned)__builtin_amdgcn_readfirstlane(kdst+(slot)))
  #define DMA_V(t,slot) do{ glds16(vsrc+(long)(t)*KVBLK*DM,(unsigned)__builtin_amdgcn_readfirstlane(vdst+2*(slot))); glds16(vsrc+64+(long)(t)*KVBLK*DM,(unsigned)__builtin_amdgcn_readfirstlane(vdst+2*(slot)+8192)); }while(0)
  const int vb0=(int)(lds0+LDS_V)+((lane>>4)&1)*32+(lane&3)*8+(4*hi+((lane&15)>>2))*64;
  const char*Kbase=shm+LDS_K; bf16x8 kf[8];
  const lds_cptr shm3=(lds_cptr)shm; const lds_cptr kp0=shm3+LDS_K+hi*1024+r32*16; const lds_cptr vp0=shm3+LDS_V+((lane>>4)&1)*32+(lane&3)*8+(4*hi+((lane&15)>>2))*64;
  const int NT=(q0+QB)/KVBLK+1;
  DMA_K(0,0);DMA_V(0,0);DMA_K(1,SLOTB);
  bf16x8 qr[4];
  #pragma unroll
  for(int d0=0;d0<4;++d0)qr[d0]=*reinterpret_cast<const bf16x8*>(&Qw[(long)r32*DM+d0*16+hi*8]);
  float mhat=0.f,l_reg=0.f;f32x16 o[4];o[0]=f32x16{};o[1]=f32x16{};o[2]=f32x16{};o[3]=f32x16{};const f32x16 negm=f32x16{};
  const int qrel=wid*QBLK+r32;
  #define CMASK(P0,P1,t) do{int jb_=(t)-(NT-4); if(jb_>=0)cmask(P0,P1,jb_,qrel,hi);}while(0)
  bool resc=false;
  #define START(P0,P1) do{ const float rm=rowmax(P0,P1); resc=false; mhat=rm; \
    _Pragma("unroll") for(int r=0;r<16;++r){P0[r]=fsub_s(P0[r],mhat);P1[r]=fsub_s(P1[r],mhat);} \
    _Pragma("unroll") for(int r=0;r<16;++r)P0[r]=__builtin_amdgcn_exp2f(P0[r]); }while(0)
  #define RESC() do{ if(resc){ asm volatile("s_waitcnt lgkmcnt(0)":::"memory"); \
      _Pragma("unroll") for(int d_=0;d_<4;++d_) _Pragma("unroll") for(int r=0;r<16;++r)o[d_][r]*=wsf[crow(r,hi)]; } }while(0)
  f32x16 pA0,pA1,pB0,pB1;
  int sl_prev=0,sl_cur=0,sl_next=SLOTB;
  #define ROT() do{sl_prev=sl_cur;sl_cur=sl_next;sl_next=(sl_next==(NSLOT-1)*SLOTB)?0:sl_next+SLOTB;}while(0)
  DMA_K(2,2*SLOTB);
  WAIT_BAR(3);
  qkt(pA0,pA1,Kbase,qr,negm,r32,hi);asm volatile("s_nop 15\n\ts_nop 7":"+v"(pA0),"+v"(pA1));
  { const float NEGI=-INFINITY; _Pragma("unroll") for(int r=0;r<16;++r)pA0[r]=NEGI; _Pragma("unroll") for(int r=0;r<8;++r)pA1[r]=NEGI; }
  START(pA0,pA1);
  _Pragma("unroll") for(int r=0;r<16;++r)pA1[r]=__builtin_amdgcn_exp2f(pA1[r]);
  WAIT_BAR(0);
  DMA_K(3,0);DMA_V(1,SLOTB);
  ROT();
  kload8(kf,kp0+sl_cur);
  WAIT_BAR(3);
  s16x4 vlo[4],vhi[4]; u32x4 pw0,pw1,pw2,pw3;
  #define PKW(P,B) cvtpk_s(P[B],P[B+1])
  #define PAF(k) __builtin_bit_cast(bf16x8,pw##k)
  #define VFR(j) (bf16x8){vlo[(j)&3][0],vlo[(j)&3][1],vlo[(j)&3][2],vlo[(j)&3][3],vhi[(j)&3][0],vhi[(j)&3][1],vhi[(j)&3][2],vhi[(j)&3][3]}
  #define PIN(x) asm volatile("":"+v"(x))
  #define MX3(a,b,c) __builtin_fmaxf(__builtin_fmaxf((a),(b)),(c))
  #define GAPA(MF,A0,A1,A2,A3,W0,W1,PW) do{ MF; sacc+=A0; sacc+=A1; sacc+=A2; sacc+=A3; PIN(sacc); W0; W1; PIN(PW); SBAR(); }while(0)
  #define EX(v) __builtin_amdgcn_exp2f(v)
  #define GAPB(MF,X,B) do{ MF; X[B]=EX(X[B]-mhat); X[B+1]=EX(X[B+1]-mhat); PIN(X); SBAR(); }while(0)
  #define VOFF(j) (((j)<8?((j)&1):2+((j)&1))*4096+(((j)&7)>>1)*1024)
  #define VRD(j) do{ vlo[(j)&3]=vtr(vp_+VOFF(j)); vhi[(j)&3]=vtr(vp_+VOFF(j)+512); }while(0)
  #define KRD(G,j) do{ if(G){ kload2(kf,kp0+sl_next,j); SBAR(); } }while(0)
  #define STEP(C0,C1,P0,P1,t,GK,GV,GL) do{ SBAR(); \
    const lds_cptr vp_=vp0+2*sl_prev; \
    VRD(0); SBAR(); float sacc=(P0[0]+P0[1]); \
    GAPA(C0=__builtin_amdgcn_mfma_f32_32x32x16_bf16(kf[0],qr[0],negm,0,0,0), P0[2],P0[3],P0[4],P0[5],     pw0[0]=PKW(P0,0), pw0[1]=PKW(P0,2), pw0); \
    VRD(1); SBAR(); GAPA(C1=__builtin_amdgcn_mfma_f32_32x32x16_bf16(kf[1],qr[0],negm,0,0,0), P0[6],P0[7],P0[8],P0[9],     pw0[2]=PKW(P0,4), pw0[3]=PKW(P0,6), pw0); \
    VRD(2); SBAR(); GAPA(C0=__builtin_amdgcn_mfma_f32_32x32x16_bf16(kf[2],qr[1],C0,0,0,0),   P0[10],P0[11],P0[12],P0[13], pw1[0]=PKW(P0,8), pw1[1]=PKW(P0,10), pw1); \
    VRD(3); SBAR(); GAPA(C1=__builtin_amdgcn_mfma_f32_32x32x16_bf16(kf[3],qr[1],C1,0,0,0),   P0[14],P0[15],P1[0],P1[1],   pw1[2]=PKW(P0,12),pw1[3]=PKW(P0,14), pw1); \
    GAPA(C0=__builtin_amdgcn_mfma_f32_32x32x16_bf16(kf[4],qr[2],C0,0,0,0),   P1[2],P1[3],P1[4],P1[5],     pw2[0]=PKW(P1,0), pw2[1]=PKW(P1,2), pw2); \
    GAPA(C1=__builtin_amdgcn_mfma_f32_32x32x16_bf16(kf[5],qr[2],C1,0,0,0),   P1[6],P1[7],P1[8],P1[9],     pw2[2]=PKW(P1,4), pw2[3]=PKW(P1,6), pw2); \
    GAPA(C0=__builtin_amdgcn_mfma_f32_32x32x16_bf16(kf[6],qr[3],C0,0,0,0),   P1[10],P1[11],P1[12],P1[13], pw3[0]=PKW(P1,8), pw3[1]=PKW(P1,10), pw3); \
    GAPA(C1=__builtin_amdgcn_mfma_f32_32x32x16_bf16(kf[7],qr[3],C1,0,0,0),   P1[14],P1[15],0.f,0.f,       pw3[2]=PKW(P1,12),pw3[3]=PKW(P1,14), pw3); \
    l_reg+=sacc; \
    if(GK){DMA_K((t)+3,sl_cur);} if(GV){DMA_V((t)+1,sl_next);} \
    CMASK(C0,C1,t); \
    { float a=MX3(C0[0],C0[1],C1[0]),b=MX3(C0[2],C0[3],C1[1]); a=MX3(a,C1[2],C1[3]); \
      _Pragma("unroll") for(int r=4;r<16;r+=4){a=MX3(a,C0[r],C0[r+1]);b=MX3(b,C0[r+2],C0[r+3]);a=MX3(a,C1[r],C1[r+1]);b=MX3(b,C1[r+2],C1[r+3]);} \
      float rm=__builtin_fmaxf(a,b); { auto rr=__builtin_amdgcn_permlane32_swap(__float_as_uint(rm),__float_as_uint(rm),false,false); rm=__builtin_fmaxf(__uint_as_float(rr[0]),__uint_as_float(rr[1])); } \
      rm-=mhat; resc=false; \
      if(__builtin_expect(__any(rm>(float)THRL),0)){ const float dl=__builtin_fmaxf(rm,0.f); mhat+=dl; \
        const float f=__builtin_amdgcn_exp2f(-dl); l_reg*=f; if(hi==0)wsf[r32]=f; resc=true; } } \
    SBAR(); \
    GAPB(o[0]=__builtin_amdgcn_mfma_f32_32x32x16_bf16(PAF(0),VFR(0),o[0],0,0,0), C0,0);  VRD(4); SBAR(); \
    GAPB(o[1]=__builtin_amdgcn_mfma_f32_32x32x16_bf16(PAF(0),VFR(1),o[1],0,0,0), C0,2);  VRD(5); SBAR(); \
    GAPB(o[0]=__builtin_amdgcn_mfma_f32_32x32x16_bf16(PAF(1),VFR(2),o[0],0,0,0), C0,4);  VRD(6); SBAR(); \
    GAPB(o[1]=__builtin_amdgcn_mfma_f32_32x32x16_bf16(PAF(1),VFR(3),o[1],0,0,0), C0,6);  VRD(7); SBAR(); \
    GAPB(o[0]=__builtin_amdgcn_mfma_f32_32x32x16_bf16(PAF(2),VFR(4),o[0],0,0,0), C0,8);  VRD(8); SBAR(); \
    GAPB(o[1]=__builtin_amdgcn_mfma_f32_32x32x16_bf16(PAF(2),VFR(5),o[1],0,0,0), C0,10); VRD(9); SBAR(); \
    GAPB(o[0]=__builtin_amdgcn_mfma_f32_32x32x16_bf16(PAF(3),VFR(6),o[0],0,0,0), C0,12); VRD(10); SBAR(); \
    GAPB(o[1]=__builtin_amdgcn_mfma_f32_32x32x16_bf16(PAF(3),VFR(7),o[1],0,0,0), C0,14); VRD(11); SBAR(); \
    GAPB(o[2]=__builtin_amdgcn_mfma_f32_32x32x16_bf16(PAF(0),VFR(8),o[2],0,0,0), C1,0);  VRD(12); SBAR(); \
    GAPB(o[3]=__builtin_amdgcn_mfma_f32_32x32x16_bf16(PAF(0),VFR(9),o[3],0,0,0), C1,2);  VRD(13); SBAR(); \
    GAPB(o[2]=__builtin_amdgcn_mfma_f32_32x32x16_bf16(PAF(1),VFR(10),o[2],0,0,0), C1,4); VRD(14); SBAR(); \
    GAPB(o[3]=__builtin_amdgcn_mfma_f32_32x32x16_bf16(PAF(1),VFR(11),o[3],0,0,0), C1,6); VRD(15); SBAR(); \
    KRD(GL,0); GAPB(o[2]=__builtin_amdgcn_mfma_f32_32x32x16_bf16(PAF(2),VFR(12),o[2],0,0,0), C1,8); \
    KRD(GL,1); GAPB(o[3]=__builtin_amdgcn_mfma_f32_32x32x16_bf16(PAF(2),VFR(13),o[3],0,0,0), C1,10); \
    KRD(GL,2); GAPB(o[2]=__builtin_amdgcn_mfma_f32_32x32x16_bf16(PAF(3),VFR(14),o[2],0,0,0), C1,12); \
    KRD(GL,3); GAPB(o[3]=__builtin_amdgcn_mfma_f32_32x32x16_bf16(PAF(3),VFR(15),o[3],0,0,0), C1,14); \
    }while(0)
  int t=1;
  #undef CMASK
  #define CMASK(P0,P1,t) do{}while(0)
  for(;t+5<NT;t+=2){
    STEP(pB0,pB1,pA0,pA1,t,true,true,true);     WAIT_BAR(3); RESC(); ROT();
    STEP(pA0,pA1,pB0,pB1,t+1,true,true,true);   WAIT_BAR(3); RESC(); ROT();
  }
  #undef CMASK
  #define CMASK(P0,P1,t) do{int jb_=(t)-(NT-4); if(jb_>=0)cmask(P0,P1,jb_,qrel,hi);}while(0)
  #define ENDW(tt) do{ if((tt)+3<NT){WAIT_BAR(3);} else if((tt)+2<NT){WAIT_BAR(2);} else {WAIT_BAR(0);} }while(0)
  for(;t+1<NT;t+=2){
    STEP(pB0,pB1,pA0,pA1,t,(t+3<NT),(t+1<NT),(t+1<NT));       ENDW(t);   RESC(); ROT();
    STEP(pA0,pA1,pB0,pB1,t+1,(t+4<NT),(t+2<NT),(t+2<NT));     ENDW(t+1); RESC(); ROT();
  }
  { float sacc=pA0[0]+pA0[1]; _Pragma("unroll") for(int r=2;r<16;++r)sacc+=pA0[r]; _Pragma("unroll") for(int r=0;r<16;++r)sacc+=pA1[r]; l_reg+=sacc;
    pw0=(u32x4){PKW(pA0,0),PKW(pA0,2),PKW(pA0,4),PKW(pA0,6)};pw1=(u32x4){PKW(pA0,8),PKW(pA0,10),PKW(pA0,12),PKW(pA0,14)};pw2=(u32x4){PKW(pA1,0),PKW(pA1,2),PKW(pA1,4),PKW(pA1,6)};pw3=(u32x4){PKW(pA1,8),PKW(pA1,10),PKW(pA1,12),PKW(pA1,14)};
    SBAR(); pv(o,vb0+2*sl_prev,PAF(0),PAF(1),PAF(2),PAF(3)); }
  #undef PKW
  #undef PAF
  #undef VFR
  #undef PIN
  #undef MX3
  #undef GAPA
  #undef GAPB
  #undef EX
  #undef VRD
  #undef VOFF
  #undef KRD
  #undef STEP
  #undef ENDW
  {auto rr=__builtin_amdgcn_permlane32_swap(__float_as_uint(l_reg),__float_as_uint(l_reg),false,false);l_reg=__uint_as_float(rr[0])+__uint_as_float(rr[1]);}
  if(hi==0)wsf[32+r32]=l_reg;asm volatile("s_waitcnt lgkmcnt(0)":::"memory");
  float rli[16];
  #pragma unroll
  for(int r=0;r<16;++r)rli[r]=__builtin_amdgcn_rcpf(wsf[32+crow(r,hi)]);
  bf16*Ow=((hq&1)?O2:O1)+(rowbase+q0+wid*QBLK)*DM+head*128;
  { bf16*stg=(bf16*)(shm+LDS_OST)+wid*2048;
    #pragma unroll
    for(int half=0;half<2;++half){
      #pragma unroll
      for(int r=0;r<16;++r){const int orow=crow(r,hi);
        #pragma unroll
        for(int d0=0;d0<2;++d0)stg[orow*64+d0*32+r32]=__float2bfloat16(o[2*half+d0][r]*rli[r]);}
      asm volatile("s_waitcnt lgkmcnt(0)":::"memory");
      #pragma unroll
      for(int i=0;i<4;++i){const int row=i*8+(lane>>3),ch=lane&7; const u32x4 v=*(const u32x4*)(stg+row*64+ch*8); ATTN_STORE16(Ow+(long)row*DM+half*64+ch*8,v);}
      asm volatile("s_waitcnt lgkmcnt(0)":::"memory"); } }
  asm volatile("s_waitcnt lgkmcnt(0)\n\ts_barrier":::"memory");
  #undef DMA_K
  #undef DMA_V
  #undef CMASK
  #undef START
  #undef RESC
  #undef ROT
}
constexpr int ATTN_LDS_BYTES=LDS_BYTES;
#undef SBAR
#undef WAIT_BAR
}

namespace mk {
using pg8::bf16_t; using pg8::f32x4; using pg8::u32x4; using pg8::Unit; using pg8::cvt_pk_bf16;
#define GAS __attribute__((address_space(1)))
#define LAS __attribute__((address_space(3)))
typedef short bf16x8 __attribute__((ext_vector_type(8)));
typedef float f32x2 __attribute__((ext_vector_type(2)));
typedef unsigned u32x2 __attribute__((ext_vector_type(2)));
constexpr int NWAVES = 8, NTHR = 512;
constexpr int NMAIN = 16384, XR0 = 16384, NMETA = 16, NSAMP = 128, RVALID = 16528, RG = 16640, NTILE = 64, SEQ = 8192, LP = 8208, KROWS = 8256, SB = 32, NPAGES = 64, DFF = 4096;
constexpr float EPS = 1e-6f, C2 = 0.125f * 1.4426950408889634f;
constexpr size_t O_YP = 0, O_YS = O_YP + (size_t)NMAIN * 1024, O_KP = O_YS + (size_t)NSAMP * 1024, O_VP = O_KP + (size_t)2 * LP * 512, O_RP = O_VP + (size_t)2 * LP * 512, O_IP = O_RP + 4096,
                 O_PP = O_IP + 4096, O_KS = O_PP + (size_t)2 * 15 * 1024, O_VS = O_KS + (size_t)NSAMP * 512, O_RS = O_VS + (size_t)NSAMP * 512, O_IS = O_RS + (size_t)SB * 2048,
                 O_PS = O_IS + (size_t)SB * 2048, O_END = O_PS + (size_t)SB * 15 * 1024;
constexpr size_t MiB = 1u << 20;
constexpr size_t WS_CTL = 0, CTL_ZERO_BYTES = 512 * 1024;
constexpr size_t WS_WIN = 2 * MiB, WS_WGLU = 6 * MiB, WS_WO = 7 * MiB, WS_POOLT = 9 * MiB, WS_WUP0 = 10 * MiB, WS_WDN0 = 18 * MiB, WS_WUP1 = 26 * MiB, WS_WDN1 = 34 * MiB;
constexpr size_t WS_S5A = 42 * MiB, WS_S5C = 46 * MiB, WS_ROPE = 52 * MiB, WS_SMETA = 53 * MiB, WS_UX = 53 * MiB + 512 * 1024, WS_XB = 54 * MiB, WS_QB = 87 * MiB, WS_KB = 104 * MiB, WS_VB = 121 * MiB;
constexpr size_t WS_A2 = 138 * MiB, WS_S5S = 162 * MiB, WS_YS = 178 * MiB, WS_O1 = 195 * MiB, WS_O2 = 212 * MiB, WS_DPART = 229 * MiB, WS_CAT = 238 * MiB, WS_X1 = 271 * MiB, WS_HB = 337 * MiB, WS_PA = 467 * MiB, WS_END = 500 * MiB;
constexpr int NDPG = 8, NDIT = 64 / NDPG, NDCH = 2 * NDIT;
constexpr int CW_TMO = 0, CW_BAR = 4096, CW_QUEUE = 8192, CW_ROWSQ = 16384;
constexpr int CW_FIN = 100352, CW_FINX = CW_FIN + 64 * 64;
constexpr int RING_OFF = 0, RING_BYTES = 131072, LDSCTL_OFF = RING_BYTES, MISC_OFF = LDSCTL_OFF + 320, LDS_BYTES = 147456;

#define RLX_AGENT __ATOMIC_RELAXED, __HIP_MEMORY_SCOPE_AGENT
__device__ __forceinline__ unsigned f2bf(float f) { unsigned u = __builtin_bit_cast(unsigned, f); return (u + 0x7fffu + ((u >> 16) & 1u)) >> 16; }
__device__ __forceinline__ unsigned pk2(float lo, float hi) { return f2bf(lo) | (f2bf(hi) << 16); }
__device__ __forceinline__ float bf2f(unsigned short b) { return __builtin_bit_cast(float, (unsigned)b << 16); }
__device__ __forceinline__ float bflo(unsigned w) { return __builtin_bit_cast(float, w << 16); }
__device__ __forceinline__ float bfhi(unsigned w) { return __builtin_bit_cast(float, w & 0xffff0000u); }

#define XB_TMO      128
#define XB_XCNT(j)  (256  + 64 * (j))
#define XB_XSUB(j)  (1280 + 64 * (j))
#define XB_XGEN(j)  (2304 + 64 * (j))
#define XB_TOP      3328
#define XB_TOPGEN   3392
#define XCD_BAR_WORDS 3456
#define XB_SPIN_CAP (1u << 18)
__device__ __forceinline__ unsigned xb_ld(unsigned* p)              { return __hip_atomic_load(p, __ATOMIC_RELAXED, __HIP_MEMORY_SCOPE_AGENT); }
__device__ __forceinline__ unsigned xb_add(unsigned* p, unsigned v) { return __hip_atomic_fetch_add(p, v, __ATOMIC_RELAXED, __HIP_MEMORY_SCOPE_AGENT); }
__device__ __forceinline__ unsigned xb_xcc_id() { return (unsigned)__builtin_amdgcn_s_getreg((3 << 11) | 20) & 0xFu; }
#define XB_SPIN(cond, bar) do { unsigned _sp = 0; while (cond) { __builtin_amdgcn_s_sleep(1); \
    if ((++_sp & 255u) == 0u) { if (xb_ld(&(bar)[XB_TMO])) break; if (_sp > XB_SPIN_CAP) { atomicAdd(&(bar)[XB_TMO], 1u); break; } } } } while (0)
struct XcdBarrier { unsigned* bar; unsigned x; volatile LAS unsigned* st; };
__device__ __forceinline__ XcdBarrier xcd_barrier_post(unsigned* bar, volatile LAS unsigned* st) {
    XcdBarrier b; b.bar = bar; b.x = xb_xcc_id(); b.st = st;
    if (threadIdx.x == 0) (void)xb_add(&bar[XB_XCNT(b.x)], 1u);
    return b;
}
__device__ __forceinline__ void xcd_barrier_complete(unsigned* bar, unsigned x, unsigned& nloc, unsigned& nx) {
    const unsigned G = gridDim.x * gridDim.y * gridDim.z;
    unsigned sum, cnt, mine, sp = 0u;
    for (;;) {
        sum = 0u; cnt = 0u; mine = 0u;
#pragma unroll
        for (unsigned j = 0; j < 16; ++j) { const unsigned c = xb_ld(&bar[XB_XCNT(j)]); sum += c; cnt += (c > 0u) ? 1u : 0u; mine = (j == x) ? c : mine; }
        if (sum == G) break;
        __builtin_amdgcn_s_sleep(1);
        if ((++sp & 255u) == 0u) { if (xb_ld(&bar[XB_TMO])) break; if (sp > XB_SPIN_CAP) { atomicAdd(&bar[XB_TMO], 1u); break; } }
    }
    nloc = mine > 0u ? mine : 1u; nx = cnt > 0u ? cnt : 1u;
}
__device__ __forceinline__ void xcd_barrier(const XcdBarrier& b) {
    asm volatile("s_waitcnt vmcnt(0)" ::: "memory");
    __syncthreads();
    if (threadIdx.x == 0) {
        unsigned* bar = b.bar;
        __builtin_amdgcn_s_waitcnt(0);
        unsigned nloc = b.st[0], nx = b.st[1];
        if (nloc == 0u) { xcd_barrier_complete(bar, b.x, nloc, nx); b.st[0] = nloc; b.st[1] = nx; }
        const unsigned old = xb_add(&bar[XB_XSUB(b.x)], 1u);
        const unsigned gen = old / nloc;
        if (old + 1u == (gen + 1u) * nloc) {
            __builtin_amdgcn_fence(__ATOMIC_RELEASE, "agent");
            asm volatile("s_waitcnt vmcnt(0)" ::: "memory");
            const unsigned og = xb_add(&bar[XB_TOP], 1u);
            const unsigned tg = og / nx;
            if (og + 1u == (tg + 1u) * nx) xb_add(&bar[XB_TOPGEN], 1u);
            else XB_SPIN(xb_ld(&bar[XB_TOPGEN]) == tg, bar);
            __builtin_amdgcn_fence(__ATOMIC_ACQUIRE, "agent");
            xb_add(&bar[XB_XGEN(b.x)], 1u);
            asm volatile("s_waitcnt vmcnt(0)" ::: "memory");
        } else {
            XB_SPIN(xb_ld(&bar[XB_XGEN(b.x)]) == gen, bar);
            __builtin_amdgcn_fence(__ATOMIC_ACQUIRE, "agent");
            asm volatile("s_waitcnt vmcnt(0)" ::: "memory");
        }
    }
    __syncthreads();
}

struct Args { const float* in[34]; float* out; unsigned char* ws; int ph_lo, ph_hi; };
struct Ctx {
    const float *x_prompt, *x_sample, *cache_k, *cache_v, *st_re, *st_im, *st_pool; const int* page_table;
    const float *meta, *norm_mix, *norm_mlp, *norm_final, *w_in, *lq1, *lk1, *lq2, *lk2, *subln, *lam_re, *lam_im, *log_dt, *b_re, *b_im, *c_re, *c_im, *s5d, *w_glu, *b_glu, *w_o, *pool_w, *pool_b, *pool_scale, *w_up, *w_down;
    float* out; unsigned char* ws; unsigned* ctl; float* rowsq;
    bf16_t *WIN, *WGLU, *WO, *POOLT, *WUP0, *WDN0, *WUP1, *WDN1, *S5A, *S5C, *XB, *XB2, *QB, *KB, *VB, *A2, *YS, *O1, *O2, *CAT, *HB, *PA;
    float *ROPE, *SMETA, *UX, *S5S, *DPART, *X1;
    LAS unsigned char* lds; volatile LAS unsigned* MISC;
    int tid, lane, wave, G, bid;
};
__device__ __forceinline__ void ctx_init(Ctx& C, const Args& a, LAS unsigned char* lds) {
    C.x_prompt = a.in[0]; C.x_sample = a.in[1]; C.cache_k = a.in[2]; C.cache_v = a.in[3]; C.st_re = a.in[4]; C.st_im = a.in[5]; C.st_pool = a.in[6]; C.page_table = (const int*)a.in[7];
    C.meta = a.in[8]; C.norm_mix = a.in[9]; C.norm_mlp = a.in[10]; C.norm_final = a.in[11]; C.w_in = a.in[12]; C.lq1 = a.in[13]; C.lk1 = a.in[14]; C.lq2 = a.in[15]; C.lk2 = a.in[16];
    C.subln = a.in[17]; C.lam_re = a.in[18]; C.lam_im = a.in[19]; C.log_dt = a.in[20]; C.b_re = a.in[21]; C.b_im = a.in[22]; C.c_re = a.in[23]; C.c_im = a.in[24]; C.s5d = a.in[25];
    C.w_glu = a.in[26]; C.b_glu = a.in[27]; C.w_o = a.in[28]; C.pool_w = a.in[29]; C.pool_b = a.in[30]; C.pool_scale = a.in[31]; C.w_up = a.in[32]; C.w_down = a.in[33];
    C.out = a.out; C.ws = a.ws; C.ctl = (unsigned*)(a.ws + WS_CTL); C.rowsq = (float*)(C.ctl + CW_ROWSQ);
    C.WIN = (bf16_t*)(a.ws + WS_WIN); C.WGLU = (bf16_t*)(a.ws + WS_WGLU); C.WO = (bf16_t*)(a.ws + WS_WO); C.POOLT = (bf16_t*)(a.ws + WS_POOLT);
    C.WUP0 = (bf16_t*)(a.ws + WS_WUP0); C.WDN0 = (bf16_t*)(a.ws + WS_WDN0); C.WUP1 = (bf16_t*)(a.ws + WS_WUP1); C.WDN1 = (bf16_t*)(a.ws + WS_WDN1);
    C.S5A = (bf16_t*)(a.ws + WS_S5A); C.S5C = (bf16_t*)(a.ws + WS_S5C); C.XB = (bf16_t*)(a.ws + WS_XB); C.XB2 = (bf16_t*)(a.ws + WS_X1); C.QB = (bf16_t*)(a.ws + WS_QB); C.KB = (bf16_t*)(a.ws + WS_KB); C.VB = (bf16_t*)(a.ws + WS_VB);
    C.A2 = (bf16_t*)(a.ws + WS_A2); C.YS = (bf16_t*)(a.ws + WS_YS); C.O1 = (bf16_t*)(a.ws + WS_O1); C.O2 = (bf16_t*)(a.ws + WS_O2); C.CAT = (bf16_t*)(a.ws + WS_CAT); C.HB = (bf16_t*)(a.ws + WS_HB); C.PA = (bf16_t*)(a.ws + WS_PA);
    C.ROPE = (float*)(a.ws + WS_ROPE); C.SMETA = (float*)(a.ws + WS_SMETA); C.UX = (float*)(a.ws + WS_UX); C.S5S = (float*)(a.ws + WS_S5S); C.DPART = (float*)(a.ws + WS_DPART); C.X1 = (float*)(a.ws + WS_X1);
    C.lds = lds; C.MISC = (volatile LAS unsigned*)(lds + MISC_OFF);
    C.tid = threadIdx.x; C.lane = C.tid & 63; C.wave = __builtin_amdgcn_readfirstlane(C.tid >> 6); C.G = gridDim.x; C.bid = blockIdx.x;
}
__device__ __forceinline__ float wave_sum(float v) {
#pragma unroll
    for (int o = 1; o < 64; o <<= 1) v += __shfl_xor(v, o);
    return v;
}
__device__ __forceinline__ const float* xin_row(const Ctx& C, int r) {
    if (r < NMAIN) return C.x_prompt + (size_t)r * 1024;
    if (r < XR0 + NMETA) return C.meta + (size_t)(r - XR0) * 1024;
    if (r < RVALID) return C.x_sample + (size_t)(r - XR0 - NMETA) * 1024;
    return nullptr;
}
__device__ __forceinline__ int row_pos(int r) { return r < NMAIN ? NMETA + (r & (SEQ - 1)) : (r < XR0 + NMETA ? r - XR0 : SEQ + ((r - XR0 - NMETA) & 3)); }
__device__ __forceinline__ float lam_full(const Ctx& C) {
    const float s1 = wave_sum(C.lq1[C.lane] * C.lk1[C.lane]), s2 = wave_sum(C.lq2[C.lane] * C.lk2[C.lane]);
    return expf(s1) - expf(s2) + 0.2f;
}

__device__ __forceinline__ void p0_transpose_item(const float* W, int ldw, int N, bf16_t* WT, int ldt, int row_off, const float* g, LAS float* scr, int item, int lane) {
    const int nblk = N / 32, kb = item / nblk, nb = item % nblk, k0 = 64 * kb, n0 = 32 * nb;
    float wv[32];
#pragma unroll
    for (int i = 0; i < 32; ++i) wv[i] = W[(size_t)(k0 + 2 * i + (lane >> 5)) * ldw + n0 + (lane & 31)];
#pragma unroll
    for (int i = 0; i < 32; ++i) { const int kk = 2 * i + (lane >> 5); float v = wv[i]; if (g) v *= g[k0 + kk]; scr[kk * 33 + (lane & 31)] = v; }
    asm volatile("s_waitcnt lgkmcnt(0)" ::: "memory");
    const int c = lane & 7;
#pragma unroll
    for (int j = 0; j < 4; ++j) { const int n = (lane >> 3) + 8 * j; const LAS float* s = scr + (8 * c) * 33 + n;
        u32x4 o; o.x = pk2(s[0 * 33], s[1 * 33]); o.y = pk2(s[2 * 33], s[3 * 33]); o.z = pk2(s[4 * 33], s[5 * 33]); o.w = pk2(s[6 * 33], s[7 * 33]);
        *(u32x4*)(WT + (size_t)(row_off + n0 + n) * ldt + k0 + 8 * c) = o; }
    asm volatile("s_waitcnt lgkmcnt(0)" ::: "memory");
}
__device__ __forceinline__ void p0_row(const Ctx& C, int r) {
    const float* src = xin_row(C, r); u32x2* o8 = (u32x2*)(C.XB + (size_t)r * 1024) + C.lane;
    if (!src) { for (int j = 0; j < 4; ++j) o8[64 * j] = (u32x2){0u, 0u}; if (C.lane == 0) C.rowsq[r] = 0.f; return; }
    const f32x4* xr = (const f32x4*)src + C.lane; float s = 0.f;
#pragma unroll
    for (int j = 0; j < 4; ++j) { const f32x4 v = xr[64 * j]; s += (v.x * v.x + v.y * v.y) + (v.z * v.z + v.w * v.w); o8[64 * j] = (u32x2){pk2(v.x, v.y), pk2(v.z, v.w)}; }
    s = wave_sum(s); if (C.lane == 0) C.rowsq[r] = s;
}
__device__ __forceinline__ void p0_rows4(const Ctx& C, int r, int stride) {
    f32x4 v[4][4]; bool have[4];
#pragma unroll
    for (int q = 0; q < 4; ++q) { const int row = r + q * stride; const float* src = row < RG ? xin_row(C, row) : nullptr; have[q] = src != nullptr;
#pragma unroll
        for (int j = 0; j < 4; ++j) v[q][j] = have[q] ? *((const f32x4*)src + 64 * j + C.lane) : (f32x4){0.f, 0.f, 0.f, 0.f}; }
#pragma unroll
    for (int q = 0; q < 4; ++q) { const int row = r + q * stride; if (row >= RG) continue; u32x2* o8 = (u32x2*)(C.XB + (size_t)row * 1024) + C.lane; float s = 0.f;
#pragma unroll
        for (int j = 0; j < 4; ++j) { const f32x4 x = v[q][j]; s += (x.x * x.x + x.y * x.y) + (x.z * x.z + x.w * x.w); o8[64 * j] = (u32x2){pk2(x.x, x.y), pk2(x.z, x.w)}; }
        s = wave_sum(s); if (C.lane == 0) C.rowsq[row] = s; }
}
__device__ __forceinline__ void p0_s5_group(const Ctx& C, int g, int sub) {
    LAS float* AP = (LAS float*)C.lds;
    LAS float* BB = AP + 17 * 64 * 2;
    LAS float* CC = BB + 64 * 16 * 2;
    LAS float* KT = CC + 16 * 64 * 2;
    const float dt = expf(C.log_dt[g]);
    for (int t = C.tid; t < 17 * 64; t += NTHR) { const int n = t & 63, lag = t >> 6; const float lr = C.lam_re[g * 64 + n], li = C.lam_im[g * 64 + n];
        const float mag = expf((float)lag * dt * lr), ang = (float)lag * dt * li; float sn, cs; sincosf(ang, &sn, &cs); AP[t * 2] = mag * cs; AP[t * 2 + 1] = mag * sn; }
    for (int t = C.tid; t < 1024; t += NTHR) { const int n = t >> 4; const float lr = C.lam_re[g * 64 + n], li = C.lam_im[g * 64 + n];
        const float mag = expf(dt * lr); float sn, cs; sincosf(dt * li, &sn, &cs); const float nr = mag * cs - 1.0f, ni = mag * sn, den = lr * lr + li * li;
        const float fre = (nr * lr + ni * li) / den, fim = (ni * lr - nr * li) / den; const float br = C.b_re[(size_t)g * 1024 + t], bi = C.b_im[(size_t)g * 1024 + t];
        BB[t * 2] = fre * br - fim * bi; BB[t * 2 + 1] = fre * bi + fim * br;
        CC[t * 2] = C.c_re[(size_t)g * 1024 + t]; CC[t * 2 + 1] = C.c_im[(size_t)g * 1024 + t]; }
    __syncthreads();
    { const int pair = C.tid & 255, nh = C.tid >> 8, cp = pair & 15, c = pair >> 4; float acc[16];
#pragma unroll
        for (int l = 0; l < 16; ++l) acc[l] = 0.f;
        for (int n = nh * 32; n < nh * 32 + 32; ++n) { const float cr = CC[(c * 64 + n) * 2], ci = CC[(c * 64 + n) * 2 + 1], br = BB[(n * 16 + cp) * 2], bi = BB[(n * 16 + cp) * 2 + 1];
            const float wr = cr * br - ci * bi, wi = cr * bi + ci * br;
#pragma unroll
            for (int l = 0; l < 16; ++l) acc[l] += wr * AP[(l * 64 + n) * 2] - wi * AP[(l * 64 + n) * 2 + 1]; }
        if (nh == 1) {
#pragma unroll
            for (int l = 0; l < 16; ++l) KT[l * 256 + pair] = acc[l]; }
        __syncthreads();
        if (nh == 0) {
#pragma unroll
            for (int l = 0; l < 16; ++l) KT[l * 256 + pair] += acc[l]; } }
    __syncthreads();
    for (int e = C.tid; e < 32 * 192; e += NTHR) { const int n = sub * 32 + e / 192, k0 = (e % 192) * 2, t = n >> 4, c = n & 15; float v[2];
#pragma unroll
        for (int q = 0; q < 2; ++q) { const int k = k0 + q;
            if (k < 256) { const int s = k >> 4, cp = k & 15; float x = 0.f; if (s <= t) { x = KT[((t - s) * 16 + c) * 16 + cp]; if (s == t && c == cp) x += C.s5d[g * 16 + c]; } v[q] = x; }
            else { const int nn = (k - 256) & 63, im = (k - 256) >> 6; const float cr = CC[(c * 64 + nn) * 2], ci = CC[(c * 64 + nn) * 2 + 1], ar = AP[((t + 1) * 64 + nn) * 2], ai = AP[((t + 1) * 64 + nn) * 2 + 1];
                v[q] = im ? -(cr * ai + ci * ar) : (cr * ar - ci * ai); } }
        *(unsigned*)(C.S5C + ((size_t)g * 256 + n) * 384 + k0) = pk2(v[0], v[1]); }
    for (int e = C.tid; e < 32 * 128; e += NTHR) { const int n = sub * 32 + e / 128, k0 = (e % 128) * 2; float v[2] = {0.f, 0.f};
        if (n < 128) { const int nn = n & 63, im = n >> 6;
#pragma unroll
            for (int q = 0; q < 2; ++q) { const int k = k0 + q, s = k >> 4, cp = k & 15; const float ar = AP[((15 - s) * 64 + nn) * 2], ai = AP[((15 - s) * 64 + nn) * 2 + 1], br = BB[(nn * 16 + cp) * 2], bi = BB[(nn * 16 + cp) * 2 + 1];
                v[q] = im ? (ar * bi + ai * br) : (ar * br - ai * bi); } }
        *(unsigned*)(C.S5A + ((size_t)g * 256 + n) * 256 + k0) = pk2(v[0], v[1]); }
    __syncthreads();
}
constexpr int LATE_GLU = 8 * 16, LATE_O = 16 * 32, LATE_POOL = 4 * 8, LATE_UP = 16 * 128, LATE_DN = 64 * 32, N_LATE = LATE_GLU + LATE_O + 4 * LATE_POOL + 2 * LATE_UP + 2 * LATE_DN;
__device__ __forceinline__ void late_weight_item(const Ctx& C, int it, LAS float* scr) {
    int r = it;
    if (r < LATE_GLU) { p0_transpose_item(C.w_glu, 512, 512, C.WGLU, 512, 0, nullptr, scr, r, C.lane); return; } r -= LATE_GLU;
    if (r < LATE_O) { p0_transpose_item(C.w_o, 1024, 1024, C.WO, 1024, 0, nullptr, scr, r, C.lane); return; } r -= LATE_O;
    if (r < 4 * LATE_POOL) { const int gi = r / LATE_POOL; p0_transpose_item(C.pool_w + (size_t)gi * 65536, 256, 256, C.POOLT, 256, gi * 256, nullptr, scr, r % LATE_POOL, C.lane); return; } r -= 4 * LATE_POOL;
    if (r < LATE_UP) { p0_transpose_item(C.w_up, 4096, 4096, C.WUP0, 1024, 0, C.norm_mlp, scr, r, C.lane); return; } r -= LATE_UP;
    if (r < LATE_DN) { p0_transpose_item(C.w_down, 1024, 1024, C.WDN0, 4096, 0, nullptr, scr, r, C.lane); return; } r -= LATE_DN;
    if (r < LATE_UP) { p0_transpose_item(C.w_up + (size_t)1024 * 4096, 4096, 4096, C.WUP1, 1024, 0, C.norm_mlp + 1024, scr, r, C.lane); return; } r -= LATE_UP;
    p0_transpose_item(C.w_down + (size_t)4096 * 1024, 1024, 1024, C.WDN1, 4096, 0, nullptr, scr, r, C.lane);
}
__device__ __forceinline__ void p0_prologue(const Ctx& C) {
    LAS float* scr = (LAS float*)(C.lds + RING_OFF + C.wave * 16384);
    const int gw = C.bid * NWAVES + C.wave, NGW = C.G * NWAVES;
#pragma unroll 1
    for (int pass = 0; pass < 2; ++pass) {
        if ((pass == 0) == (((C.bid >> 3) & 1) != 0)) {
            for (int j = C.bid; j < 256; j += C.G) p0_s5_group(C, j >> 3, 7 - (j & 7));
        } else {
            for (int it = gw; it < 16 * 64; it += NGW) p0_transpose_item(C.w_in, 2048, 2048, C.WIN, 1024, 0, C.norm_mix, scr, it, C.lane);
            for (int m = gw; m < RG; m += 4 * NGW) p0_rows4(C, m, NGW);
        }
        __syncthreads();
    }
    for (int i = C.bid * NTHR + C.tid; i < LP * 8; i += C.G * NTHR) { const int pos = i >> 3, j = i & 7; const float inv = powf(500000.0f, -(float)j / 8.0f), ang = (float)pos * inv; float sn, cs; sincosf(ang, &sn, &cs);
        C.ROPE[2 * i] = cs; C.ROPE[2 * i + 1] = sn; }
    for (int i = C.bid * NTHR + C.tid; i < 2 * 48 * 64; i += C.G * NTHR) { const int b = i / (48 * 64), rem = i % (48 * 64);
        ((u32x4*)(C.KB + (size_t)b * KROWS * 512))[rem] = (u32x4){0u, 0u, 0u, 0u}; ((u32x4*)(C.VB + (size_t)b * KROWS * 512))[rem] = (u32x4){0u, 0u, 0u, 0u}; }
}

struct NoPre {};
struct EpiProj {
    Ctx C; static constexpr int GM = 2;
    struct Pre { float rinv; f32x4 t[4]; }; typedef NoPre CPre;
    __device__ __forceinline__ CPre cpre(int) const { return CPre{}; }
    template <int XM> __device__ __forceinline__ Pre pre(int row, int col, int fq) const {
        Pre p; p.rinv = __builtin_amdgcn_rsqf(C.rowsq[row] * (1.0f / 1024.0f) + EPS);
        const bool rot = ((col >> 9) < 2) && ((col & 32) == 0) && (fq < 2) && (row < RVALID);
#pragma unroll
        for (int q = 0; q < 4; ++q) p.t[q] = (f32x4){1.f, 0.f, 1.f, 0.f};
        if (rot) { const f32x4* tp = (const f32x4*)(C.ROPE + (size_t)row_pos(row) * 16);
#pragma unroll
            for (int q = 0; q < 4; ++q) p.t[q] = tp[q]; }
        return p;
    }
    template <int XM> __device__ __forceinline__ float seg(int row, int col, const f32x4& a, const f32x4& d, int fq, const Pre& p, const CPre&) const {
        const int sec = col >> 9, csec = col & 511; const bool rot = (sec < 2) && ((csec & 32) == 0) && (fq < 2);
        float v[8];
#pragma unroll
        for (int j = 0; j < 4; ++j) { v[j] = a[j] * p.rinv; v[4 + j] = d[j] * p.rinv; }
        if (sec < 2) {
#pragma unroll
            for (int j = 0; j < 8; ++j) { const float cs = p.t[j >> 1][(j & 1) * 2], sn = p.t[j >> 1][(j & 1) * 2 + 1]; const float x = __shfl_xor(v[j], XM); if (rot) v[j] = (fq == 0) ? v[j] * cs - x * sn : v[j] * cs + x * sn; }
        }
        if (row >= RVALID) return 0.f;
        if (sec == 0) {
            u32x4 w; w.x = cvt_pk_bf16(v[0] * C2, v[1] * C2); w.y = cvt_pk_bf16(v[2] * C2, v[3] * C2); w.z = cvt_pk_bf16(v[4] * C2, v[5] * C2); w.w = cvt_pk_bf16(v[6] * C2, v[7] * C2);
            *(u32x4*)(C.QB + (size_t)row * 512 + csec) = w;
        } else if (sec < 3) {
            const f32x4 lo = {v[0], v[1], v[2], v[3]}, hi = {v[4], v[5], v[6], v[7]};
            u32x4 w; w.x = cvt_pk_bf16(v[0], v[1]); w.y = cvt_pk_bf16(v[2], v[3]); w.z = cvt_pk_bf16(v[4], v[5]); w.w = cvt_pk_bf16(v[6], v[7]);
            bf16_t* KV = sec == 1 ? C.KB : C.VB; float* OP = C.out + (sec == 1 ? O_KP : O_VP); float* OS = C.out + (sec == 1 ? O_KS : O_VS);
            if (row < NMAIN) { const int b = row >> 13, i = row & (SEQ - 1);
                float* o = OP + ((size_t)b * LP + NMETA + i) * 512 + csec; *(f32x4*)o = lo; *(f32x4*)(o + 4) = hi;
                *(u32x4*)(KV + ((size_t)b * KROWS + 64 + i) * 512 + csec) = w;
            } else if (row < XR0 + NMETA) { const int j = row - XR0;
#pragma unroll
                for (int b = 0; b < 2; ++b) { float* o = OP + ((size_t)b * LP + j) * 512 + csec; *(f32x4*)o = lo; *(f32x4*)(o + 4) = hi;
                    *(u32x4*)(KV + ((size_t)b * KROWS + 48 + j) * 512 + csec) = w; }
            } else { float* o = OS + (size_t)(row - XR0 - NMETA) * 512 + csec; *(f32x4*)o = lo; *(f32x4*)(o + 4) = hi; }
        } else {
            if (row < NMAIN) { const int b = row >> 13, i = row & (SEQ - 1), g = csec >> 4, c0 = csec & 15;
                u32x4 w; w.x = cvt_pk_bf16(v[0], v[1]); w.y = cvt_pk_bf16(v[2], v[3]); w.z = cvt_pk_bf16(v[4], v[5]); w.w = cvt_pk_bf16(v[6], v[7]);
                *(u32x4*)(C.A2 + ((size_t)g * 1024 + b * 512 + (i >> 4)) * 384 + (i & 15) * 16 + c0) = w;
            } else { float* o = C.UX + (size_t)(row - XR0) * 512 + csec; *(f32x4*)o = (f32x4){v[0], v[1], v[2], v[3]}; *(f32x4*)(o + 4) = (f32x4){v[4], v[5], v[6], v[7]}; }
        }
        return 0.f;
    }
    template <int XM> __device__ __forceinline__ void finish(int, float, int) const {}
};
__device__ __forceinline__ float gelu_tanh(float x) { const float t2 = -2.302208198f * (x + 0.044715f * x * x * x); return x * __builtin_amdgcn_rcpf(1.0f + __builtin_amdgcn_exp2f(t2)); }
struct EpiGlu {
    Ctx C; static constexpr int GM = 4;
    struct Pre { u32x4 y; }; struct CPre { f32x4 b0, b1; };
    __device__ __forceinline__ CPre cpre(int col) const { return CPre{*(const f32x4*)(C.b_glu + col), *(const f32x4*)(C.b_glu + col + 4)}; }
    template <int XM> __device__ __forceinline__ Pre pre(int row, int col, int) const { return Pre{*(const u32x4*)(C.YS + (size_t)row * 512 + col)}; }
    template <int XM> __device__ __forceinline__ float seg(int row, int col, const f32x4& a0, const f32x4& d0, int, const Pre& p, const CPre& cp) const {
        const f32x4 a = a0 + cp.b0, d = d0 + cp.b1; const u32x4 y = p.y; float o[8];
        o[0] = bflo(y.x) * __builtin_amdgcn_rcpf(1.f + __expf(-a[0])); o[1] = bfhi(y.x) * __builtin_amdgcn_rcpf(1.f + __expf(-a[1])); o[2] = bflo(y.y) * __builtin_amdgcn_rcpf(1.f + __expf(-a[2])); o[3] = bfhi(y.y) * __builtin_amdgcn_rcpf(1.f + __expf(-a[3]));
        o[4] = bflo(y.z) * __builtin_amdgcn_rcpf(1.f + __expf(-d[0])); o[5] = bfhi(y.z) * __builtin_amdgcn_rcpf(1.f + __expf(-d[1])); o[6] = bflo(y.w) * __builtin_amdgcn_rcpf(1.f + __expf(-d[2])); o[7] = bfhi(y.w) * __builtin_amdgcn_rcpf(1.f + __expf(-d[3]));
        u32x4 w; w.x = cvt_pk_bf16(o[0], o[1]); w.y = cvt_pk_bf16(o[2], o[3]); w.z = cvt_pk_bf16(o[4], o[5]); w.w = cvt_pk_bf16(o[6], o[7]);
        *(u32x4*)(C.CAT + (size_t)row * 1024 + 512 + col) = w; return 0.f;
    }
    template <int XM> __device__ __forceinline__ void finish(int, float, int) const {}
};
template <int MODE> struct EpiResid {
    Ctx C; int slot; bf16_t* XO; const bf16_t* XI;     static constexpr int GM = 4;
    struct Pre { u32x4 x; }; struct CPre { f32x4 pb0, pb1, ps0, ps1; };
    __device__ __forceinline__ CPre cpre(int col) const { CPre c; if (MODE == 2) { c.pb0 = *(const f32x4*)(C.pool_b + col); c.pb1 = *(const f32x4*)(C.pool_b + col + 4); c.ps0 = *(const f32x4*)(C.pool_scale + col); c.ps1 = *(const f32x4*)(C.pool_scale + col + 4); }
        else { c.pb0 = (f32x4){0.f, 0.f, 0.f, 0.f}; c.pb1 = c.pb0; c.ps0 = c.pb0; c.ps1 = c.pb0; } return c; }
    template <int XM> __device__ __forceinline__ Pre pre(int row, int col, int) const { Pre p;
        p.x = *(const u32x4*)(XI + (size_t)row * 1024 + col);
        return p; }
    template <int XM> __device__ __forceinline__ float seg(int row, int col, const f32x4& a0, const f32x4& d0, int, const Pre& p, const CPre& cp) const {
        f32x4 a = a0, d = d0;
        if (MODE == 2) { a = (a + cp.pb0) * cp.ps0; d = (d + cp.pb1) * cp.ps1; }
        { const u32x4 x = p.x; a += (f32x4){bflo(x.x), bfhi(x.x), bflo(x.y), bfhi(x.y)}; d += (f32x4){bflo(x.z), bfhi(x.z), bflo(x.w), bfhi(x.w)}; }
        u32x4 w; w.x = cvt_pk_bf16(a[0], a[1]); w.y = cvt_pk_bf16(a[2], a[3]); w.z = cvt_pk_bf16(d[0], d[1]); w.w = cvt_pk_bf16(d[2], d[3]); *(u32x4*)(XO + (size_t)row * 1024 + col) = w;
        return (a[0] * a[0] + a[1] * a[1]) + (a[2] * a[2] + a[3] * a[3]) + (d[0] * d[0] + d[1] * d[1]) + (d[2] * d[2] + d[3] * d[3]);
    }
    template <int XM> __device__ __forceinline__ void finish(int row, float ss, int fq) const { ss += __shfl_xor(ss, XM); ss += __shfl_xor(ss, 2 * XM); if (fq == 0) atomicAdd(C.rowsq + (size_t)slot * RG + row, ss); }
};
struct EpiUp {
    Ctx C; int slot; static constexpr int GM = 4;
    struct Pre { float rinv; }; typedef NoPre CPre;
    __device__ __forceinline__ CPre cpre(int) const { return CPre{}; }
    template <int XM> __device__ __forceinline__ Pre pre(int row, int, int) const { return Pre{__builtin_amdgcn_rsqf(C.rowsq[(size_t)slot * RG + row] * (1.0f / 1024.0f) + EPS)}; }
    template <int XM> __device__ __forceinline__ float seg(int row, int col, const f32x4& a, const f32x4& d, int, const Pre& p, const CPre&) const {
        float o[8];
#pragma unroll
        for (int j = 0; j < 4; ++j) { const float x = fmaxf(a[j] * p.rinv, 0.f), y = fmaxf(d[j] * p.rinv, 0.f); o[j] = x * x; o[4 + j] = y * y; }
        u32x4 w; w.x = cvt_pk_bf16(o[0], o[1]); w.y = cvt_pk_bf16(o[2], o[3]); w.z = cvt_pk_bf16(o[4], o[5]); w.w = cvt_pk_bf16(o[6], o[7]);
        *(u32x4*)(C.HB + (size_t)row * DFF + col) = w; return 0.f;
    }
    template <int XM> __device__ __forceinline__ void finish(int, float, int) const {}
};
__device__ __forceinline__ f32x4 lane_perm4(const f32x4& v, int srca) {
    const float x = __int_as_float(__builtin_amdgcn_ds_bpermute(srca, __float_as_int(v.x))), y = __int_as_float(__builtin_amdgcn_ds_bpermute(srca, __float_as_int(v.y)));
    const float z = __int_as_float(__builtin_amdgcn_ds_bpermute(srca, __float_as_int(v.z))), w = __int_as_float(__builtin_amdgcn_ds_bpermute(srca, __float_as_int(v.w)));
    return (f32x4){x, y, z, w};
}
template <class SE> struct EpiTile {
    SE E;
    __device__ __forceinline__ void operator()(const f32x4 (&acc)[2][2][4][2], const Unit& u, int wr, int wc, int fr, int fq) const {
        const int L = fq * 16 + fr, srca = (((L & 3) << 4) | (L >> 2)) << 2, fr2 = L >> 2, fq2 = L & 3;
        constexpr int GM = SE::GM;
        const int col0 = u.pn * 256 + wc * 32 + 8 * fq2, rowb = u.pm * 256 + wr * 64 + fr2;
        typename SE::CPre cp[2] = {E.cpre(col0), E.cpre(col0 + 128)};
#pragma unroll
        for (int ai = 0; ai < 2; ++ai)
#pragma unroll
            for (int mg = 0; mg < 4; mg += GM) {
                typename SE::Pre pre[GM][2];
#pragma unroll
                for (int mm = 0; mm < GM; ++mm)
#pragma unroll
                    for (int bj = 0; bj < 2; ++bj) pre[mm][bj] = E.template pre<1>(rowb + ai * 128 + (mg + mm) * 16, col0 + bj * 128, fq2);
#pragma unroll
                for (int mm = 0; mm < GM; ++mm) { const int m = mg + mm, row = rowb + ai * 128 + m * 16; float ss = 0.f;
#pragma unroll
                    for (int bj = 0; bj < 2; ++bj) ss += E.template seg<1>(row, col0 + bj * 128, lane_perm4(acc[ai][bj][m][0], srca), lane_perm4(acc[ai][bj][m][1], srca), fq2, pre[mm][bj], cp[bj]);
                    E.template finish<1>(row, ss, fq2); } }
    }
};
struct EpiFinal {
    Ctx C; unsigned* pcnt;
    __device__ __forceinline__ void operator()(f32x4 (&acc)[2][2][4][2], const Unit& u, int wr, int wc, int fr, int fq) const {
        const int L = fq * 16 + fr, srca = (((L & 3) << 4) | (L >> 2)) << 2, fr2 = L >> 2, fq2 = L & 3;
        const int col0 = u.pn * 256 + wc * 32 + 8 * fq2, rowb = u.pm * 256 + wr * 64 + fr2;
        float* rs = C.rowsq + (size_t)4 * RG;
#pragma unroll
        for (int ai = 0; ai < 2; ++ai) {
            u32x4 pre[4][2];
#pragma unroll
            for (int m = 0; m < 4; ++m)
#pragma unroll
                for (int bj = 0; bj < 2; ++bj) pre[m][bj] = *(const u32x4*)(C.XB2 + (size_t)(rowb + ai * 128 + m * 16) * 1024 + col0 + bj * 128);
#pragma unroll
            for (int m = 0; m < 4; ++m) { const int row = rowb + ai * 128 + m * 16; float ss = 0.f;
#pragma unroll
                for (int bj = 0; bj < 2; ++bj) { f32x4 a = lane_perm4(acc[ai][bj][m][0], srca), d = lane_perm4(acc[ai][bj][m][1], srca); const u32x4 x = pre[m][bj];
                    a += (f32x4){bflo(x.x), bfhi(x.x), bflo(x.y), bfhi(x.y)}; d += (f32x4){bflo(x.z), bfhi(x.z), bflo(x.w), bfhi(x.w)};
                    acc[ai][bj][m][0] = a; acc[ai][bj][m][1] = d;
                    ss += (a[0] * a[0] + a[1] * a[1]) + (a[2] * a[2] + a[3] * a[3]) + (d[0] * d[0] + d[1] * d[1]) + (d[2] * d[2] + d[3] * d[3]); }
                ss += __shfl_xor(ss, 1); ss += __shfl_xor(ss, 2); if (fq2 == 0) atomicAdd(rs + row, ss); } }
        asm volatile("s_waitcnt vmcnt(0)" ::: "memory"); __builtin_amdgcn_s_barrier(); asm volatile("" ::: "memory");
        if (threadIdx.x == 0) __hip_atomic_fetch_add(pcnt + 64 * u.pm, 1u, RLX_AGENT);
        if (wr == 0 && wc == 0) { unsigned sp = 0; while (__hip_atomic_load(pcnt + 64 * u.pm, RLX_AGENT) < 4u && ++sp < (1u << 22)) __builtin_amdgcn_s_sleep(1);
            __builtin_amdgcn_fence(__ATOMIC_ACQUIRE, "agent"); }
        asm volatile("s_waitcnt vmcnt(0)" ::: "memory"); __builtin_amdgcn_s_barrier(); asm volatile("" ::: "memory");
        f32x4 g[2][2];
#pragma unroll
        for (int bj = 0; bj < 2; ++bj) { g[bj][0] = *(const f32x4*)(C.norm_final + col0 + bj * 128); g[bj][1] = *(const f32x4*)(C.norm_final + col0 + bj * 128 + 4); }
#pragma unroll
        for (int ai = 0; ai < 2; ++ai) {
            float ri[4];
#pragma unroll
            for (int m = 0; m < 4; ++m) ri[m] = __builtin_amdgcn_rsqf(__uint_as_float(__hip_atomic_load((unsigned*)(rs + rowb + ai * 128 + m * 16), RLX_AGENT)) * (1.0f / 1024.0f) + EPS);
#pragma unroll
            for (int m = 0; m < 4; ++m) { float* o = C.out + O_YP + (size_t)(rowb + ai * 128 + m * 16) * 1024 + col0;
#pragma unroll
                for (int bj = 0; bj < 2; ++bj) { *(f32x4*)(o + bj * 128) = acc[ai][bj][m][0] * ri[m] * g[bj][0]; *(f32x4*)(o + bj * 128 + 4) = acc[ai][bj][m][1] * ri[m] * g[bj][1]; } } }
    }
};
#define EPI_ROWS(u, ai, m) ((u).pm * 256 + (ai) * 128 + wr * 64 + (m) * 16 + fr)
struct EpiS5a {
    Ctx C;
    __device__ __forceinline__ void operator()(const f32x4 (&acc)[2][2][4][2], const Unit& u, int wr, int wc, int fr, int fq) const {
#pragma unroll
        for (int ai = 0; ai < 2; ++ai)
#pragma unroll
            for (int m = 0; m < 4; ++m) { const int row = EPI_ROWS(u, ai, m); const int col = wc * 32 + 8 * fq;
                float* o = C.S5S + ((size_t)u.pb * 1024 + row) * 128 + col; *(f32x4*)o = acc[ai][0][m][0]; *(f32x4*)(o + 4) = acc[ai][0][m][1]; }
    }
};
struct EpiS5c {
    Ctx C;
    __device__ __forceinline__ void operator()(const f32x4 (&acc)[2][2][4][2], const Unit& u, int wr, int wc, int fr, int fq) const {
#pragma unroll
        for (int ai = 0; ai < 2; ++ai)
#pragma unroll
            for (int m = 0; m < 4; ++m) { const int cr = EPI_ROWS(u, ai, m), b = cr >> 9, j = cr & 511;
#pragma unroll
                for (int bj = 0; bj < 2; ++bj) { const int n = bj * 128 + wc * 32 + 8 * fq, t = n >> 4, c0 = n & 15; const f32x4 a = acc[ai][bj][m][0], d = acc[ai][bj][m][1];
                    u32x4 w; w.x = cvt_pk_bf16(gelu_tanh(a[0]), gelu_tanh(a[1])); w.y = cvt_pk_bf16(gelu_tanh(a[2]), gelu_tanh(a[3])); w.z = cvt_pk_bf16(gelu_tanh(d[0]), gelu_tanh(d[1])); w.w = cvt_pk_bf16(gelu_tanh(d[2]), gelu_tanh(d[3]));
                    *(u32x4*)(C.YS + ((size_t)b * SEQ + 16 * j + t) * 512 + u.pb * 16 + c0) = w; } }
    }
};
template <int RC, int PL, class SE>
__device__ __forceinline__ void xgemm(const Ctx& C, const bf16_t* A, int lda, const bf16_t* Bt, int ldb, int N, int K, int a_blk, const SE& E, LAS unsigned char* lds) {
    constexpr int LR = PL / 8, RPL = 64 / LR, NA = RC * 16 / RPL, NB = 32 / RPL, RS = PL * 2 + 16, KS = PL / 32;
    static_assert((RC * 16) % RPL == 0 && (RC * 16 + 32) * RS <= 16384 && RC * 2 * 1024 <= 16384, "xgemm geometry");
    typedef __attribute__((address_space(3))) const bf16x8* lfrag;
    const int ncg = N / 32, nunits = ncg * (10 / RC), fr = C.lane & 15, fq = C.lane >> 4, kw = K / 8, k0 = C.wave * kw, np = kw / PL;
    const int lrow = C.lane / LR, lpc = C.lane % LR;
    LAS unsigned char* st = lds + C.wave * 16384;
    LAS f32x4* red = (LAS f32x4*)st;
    for (int u = C.bid; u < nunits; u += C.G) {
        const int cg = u % ncg, rc = u / ncg;
        f32x4 acc[RC][2];
#pragma unroll
        for (int r = 0; r < RC; ++r) { acc[r][0] = (f32x4){0.f, 0.f, 0.f, 0.f}; acc[r][1] = (f32x4){0.f, 0.f, 0.f, 0.f}; }
        const bf16_t* ap = A + (size_t)(XR0 + rc * RC * 16 + lrow) * lda + (size_t)(cg >> 3) * a_blk + k0 + 8 * lpc;
        const bf16_t* bp = Bt + (size_t)(32 * cg + lrow) * ldb + k0 + 8 * lpc;
        u32x4 a0[NA], b0[NB], a1[NA], b1[NB], a2[NA], b2[NB];
#define XG_LOAD(RA, RB, pp) do { _Pragma("unroll") for (int j = 0; j < NA; ++j) RA[j] = *(const u32x4*)(ap + (size_t)j * RPL * lda + (pp) * PL); \
        _Pragma("unroll") for (int j = 0; j < NB; ++j) RB[j] = *(const u32x4*)(bp + (size_t)j * RPL * ldb + (pp) * PL); } while (0)
#define XG_PASS(RA, RB) do { \
        _Pragma("unroll") for (int j = 0; j < NA; ++j) *(LAS u32x4*)(st + (j * RPL + lrow) * RS + lpc * 16) = RA[j]; \
        _Pragma("unroll") for (int j = 0; j < NB; ++j) *(LAS u32x4*)(st + (RC * 16 + j * RPL + lrow) * RS + lpc * 16) = RB[j]; \
        asm volatile("s_waitcnt lgkmcnt(0)" ::: "memory"); \
        _Pragma("unroll") for (int s = 0; s < KS; ++s) { \
            const bf16x8 b0_ = *(lfrag)(st + (RC * 16 + 8 * (fr >> 2) + (fr & 3)) * RS + s * 64 + fq * 16), b1_ = *(lfrag)(st + (RC * 16 + 8 * (fr >> 2) + 4 + (fr & 3)) * RS + s * 64 + fq * 16); \
            _Pragma("unroll") for (int r = 0; r < RC; ++r) { const bf16x8 af = *(lfrag)(st + (r * 16 + fr) * RS + s * 64 + fq * 16); \
                acc[r][0] = __builtin_amdgcn_mfma_f32_16x16x32_bf16(b0_, af, acc[r][0], 0, 0, 0); acc[r][1] = __builtin_amdgcn_mfma_f32_16x16x32_bf16(b1_, af, acc[r][1], 0, 0, 0); } } \
        asm volatile("s_waitcnt lgkmcnt(0)" ::: "memory"); } while (0)
        XG_LOAD(a0, b0, 0); if (np > 1) XG_LOAD(a1, b1, 1);
#pragma unroll
        for (int p = 0; p < np; p += 3) {
            if (p + 2 < np) XG_LOAD(a2, b2, p + 2);
            XG_PASS(a0, b0);
            if (p + 1 < np) { if (p + 3 < np) XG_LOAD(a0, b0, p + 3); XG_PASS(a1, b1); }
            if (p + 2 < np) { if (p + 4 < np) XG_LOAD(a1, b1, p + 4); XG_PASS(a2, b2); }
        }
#undef XG_LOAD
#undef XG_PASS
#pragma unroll
        for (int r = 0; r < RC; ++r) { red[(r * 2 + 0) * 64 + C.lane] = acc[r][0]; red[(r * 2 + 1) * 64 + C.lane] = acc[r][1]; }
        __syncthreads();
        if (C.wave < RC) { const int r = C.wave; f32x4 a = (f32x4){0.f, 0.f, 0.f, 0.f}, d = a;
#pragma unroll
            for (int w = 0; w < 8; ++w) { const LAS f32x4* rw = (const LAS f32x4*)(lds + w * 16384); a += rw[(r * 2 + 0) * 64 + C.lane]; d += rw[(r * 2 + 1) * 64 + C.lane]; }
            const int row = XR0 + (rc * RC + r) * 16 + fr, col = 32 * cg + 8 * fq; const typename SE::CPre cp = E.cpre(col); const typename SE::Pre pr = E.template pre<16>(row, col, fq);
            const float ss = E.template seg<16>(row, col, a, d, fq, pr, cp); E.template finish<16>(row, ss, fq); }
        __syncthreads();
    }
}
}

namespace mk {
__device__ __forceinline__ float reduce16(float (&v)[16], int lane) {
    float w8[8], w4[4], w2[2], w1;
    { const bool up = lane & 32;
#pragma unroll
      for (int i = 0; i < 8; ++i) { const float snd = up ? v[i] : v[i + 8], keep = up ? v[i + 8] : v[i]; w8[i] = keep + __shfl_xor(snd, 32); } }
    { const bool up = lane & 16;
#pragma unroll
      for (int i = 0; i < 4; ++i) { const float snd = up ? w8[i] : w8[i + 4], keep = up ? w8[i + 4] : w8[i]; w4[i] = keep + __shfl_xor(snd, 16); } }
    { const bool up = lane & 8;
#pragma unroll
      for (int i = 0; i < 2; ++i) { const float snd = up ? w4[i] : w4[i + 2], keep = up ? w4[i + 2] : w4[i]; w2[i] = keep + __shfl_xor(snd, 8); } }
    { const bool up = lane & 4; const float snd = up ? w2[0] : w2[1], keep = up ? w2[1] : w2[0]; w1 = keep + __shfl_xor(snd, 4); }
    w1 += __shfl_xor(w1, 1); w1 += __shfl_xor(w1, 2); return w1;
}
__device__ __forceinline__ void s5x_item(const Ctx& C, int item) {
    const int g = item & 31, seq = item >> 5, n = C.lane;
    const float lr = C.lam_re[g * 64 + n], li = C.lam_im[g * 64 + n], dt = expf(C.log_dt[g]);
    const float mag = expf(lr * dt); float sn, cs; sincosf(li * dt, &sn, &cs); const float are = mag * cs, aim = mag * sn;
    const float nr = are - 1.0f, ni = aim, den = lr * lr + li * li, fre = (nr * lr + ni * li) / den, fim = (ni * lr - nr * li) / den;
    float bbr[16], bbi[16], ccr[16], cci[16];
#pragma unroll
    for (int c = 0; c < 16; ++c) { const float br = C.b_re[((size_t)g * 64 + n) * 16 + c], bi = C.b_im[((size_t)g * 64 + n) * 16 + c]; bbr[c] = fre * br - fim * bi; bbi[c] = fre * bi + fim * br;
        ccr[c] = C.c_re[((size_t)g * 16 + c) * 64 + n]; cci[c] = C.c_im[((size_t)g * 16 + c) * 64 + n]; }
    float hr = 0.f, hi = 0.f; int L = NMETA, x0 = 0;
    if (seq > 0) { const int sb = seq - 1; hr = C.st_re[((size_t)sb * 32 + g) * 64 + n]; hi = C.st_im[((size_t)sb * 32 + g) * 64 + n]; L = 4; x0 = NMETA + sb * 4; }
    const int cme = ((n >> 5) & 1) * 8 + ((n >> 4) & 1) * 4 + ((n >> 3) & 1) * 2 + ((n >> 2) & 1);
    const float dme = C.s5d[g * 16 + cme];
    f32x4 un[4]; { const f32x4* up = (const f32x4*)(C.UX + (size_t)x0 * 512 + g * 16); un[0] = up[0]; un[1] = up[1]; un[2] = up[2]; un[3] = up[3]; }
    for (int t = 0; t < L; ++t) {
        float uv[16];
#pragma unroll
        for (int c = 0; c < 16; ++c) uv[c] = un[c >> 2][c & 3];
        if (t + 1 < L) { const f32x4* up = (const f32x4*)(C.UX + (size_t)(x0 + t + 1) * 512 + g * 16); un[0] = up[0]; un[1] = up[1]; un[2] = up[2]; un[3] = up[3]; }
        float ur = 0.f, ui = 0.f;
#pragma unroll
        for (int c = 0; c < 16; ++c) { ur += bbr[c] * uv[c]; ui += bbi[c] * uv[c]; }
        const float tr = are * hr - aim * hi + ur, ti = are * hi + aim * hr + ui; hr = tr; hi = ti;
        float pv[16];
#pragma unroll
        for (int c = 0; c < 16; ++c) pv[c] = ccr[c] * hr - cci[c] * hi;
        const float ysum = reduce16(pv, n);
        float ume = 0.f;
#pragma unroll
        for (int c = 0; c < 16; ++c) ume = (c == cme) ? uv[c] : ume;
        if ((n & 3) == 0) C.YS[(size_t)(XR0 + x0 + t) * 512 + g * 16 + cme] = (bf16_t)f2bf(gelu_tanh(ysum + dme * ume));
    }
    if (seq == 0) { C.SMETA[(g * 64 + n) * 2] = hr; C.SMETA[(g * 64 + n) * 2 + 1] = hi; }
    else { const int sb = seq - 1; C.out[O_RS + ((size_t)sb * 32 + g) * 64 + n] = hr; C.out[O_IS + ((size_t)sb * 32 + g) * 64 + n] = hi; }
}
__device__ __forceinline__ void meta_attn_item(const Ctx& C, int item) {
    const int hm = item & 7, j = item >> 3, head = hm >> 1, m = hm & 1, lane = C.lane, k = lane & 15, dp = lane >> 4;
    const u32x4* qp = (const u32x4*)(C.QB + (size_t)(XR0 + j) * 512 + hm * 64 + dp * 16); const u32x4* kp = (const u32x4*)(C.KB + (size_t)(48 + k) * 512 + hm * 64 + dp * 16);
    float a = 0.f;
#pragma unroll
    for (int q = 0; q < 2; ++q) { const u32x4 x = qp[q], y = kp[q];
        a += bflo(x.x) * bflo(y.x) + bfhi(x.x) * bfhi(y.x) + bflo(x.y) * bflo(y.y) + bfhi(x.y) * bfhi(y.y) + bflo(x.z) * bflo(y.z) + bfhi(x.z) * bfhi(y.z) + bflo(x.w) * bflo(y.w) + bfhi(x.w) * bfhi(y.w); }
    a += __shfl_xor(a, 16); a += __shfl_xor(a, 32);
    const float s = (k <= j) ? a : -INFINITY; float mx = s;
    mx = fmaxf(mx, __shfl_xor(mx, 1)); mx = fmaxf(mx, __shfl_xor(mx, 2)); mx = fmaxf(mx, __shfl_xor(mx, 4)); mx = fmaxf(mx, __shfl_xor(mx, 8));
    const float p = __builtin_amdgcn_exp2f(s - mx); float l = p; l += __shfl_xor(l, 1); l += __shfl_xor(l, 2); l += __shfl_xor(l, 4); l += __shfl_xor(l, 8);
    float o0 = 0.f, o1 = 0.f;
#pragma unroll
    for (int kk = 0; kk < 16; ++kk) { const float pk = __shfl(p, kk); const unsigned v = *(const unsigned*)(C.VB + (size_t)(48 + kk) * 512 + head * 128 + 2 * lane); o0 += pk * bflo(v); o1 += pk * bfhi(v); }
    const float il = 1.0f / l; *(unsigned*)((m ? C.O2 : C.O1) + (size_t)(XR0 + j) * 512 + head * 128 + 2 * lane) = pk2(o0 * il, o1 * il);
}
__device__ __forceinline__ void s5_scan_item(const Ctx& C, int item) {
    const int g = item & 31, b = item >> 5, n = C.lane;
    const float lr = C.lam_re[g * 64 + n], li = C.lam_im[g * 64 + n], dt = expf(C.log_dt[g]);
    const float mag = expf(16.0f * lr * dt); float sn, cs; sincosf(16.0f * li * dt, &sn, &cs); const float are = mag * cs, aim = mag * sn;
    float hr = C.SMETA[(g * 64 + n) * 2], hi = C.SMETA[(g * 64 + n) * 2 + 1];
    const float* S = C.S5S + ((size_t)g * 1024 + b * 512) * 128 + n; bf16_t* H = C.A2 + ((size_t)g * 1024 + b * 512) * 384 + 256 + n;
    float sr[16], si[16], nr[16], ni[16];
#pragma unroll
    for (int k = 0; k < 16; ++k) { nr[k] = S[(size_t)k * 128]; ni[k] = S[(size_t)k * 128 + 64]; }
#pragma unroll 1
    for (int j0 = 0; j0 < 512; j0 += 16) {
#pragma unroll
        for (int k = 0; k < 16; ++k) { sr[k] = nr[k]; si[k] = ni[k]; }
        if (j0 + 16 < 512) {
#pragma unroll
            for (int k = 0; k < 16; ++k) { nr[k] = S[(size_t)(j0 + 16 + k) * 128]; ni[k] = S[(size_t)(j0 + 16 + k) * 128 + 64]; } }
#pragma unroll
        for (int k = 0; k < 16; ++k) { H[(size_t)(j0 + k) * 384] = (bf16_t)f2bf(hr); H[(size_t)(j0 + k) * 384 + 64] = (bf16_t)f2bf(hi);
            const float tr = are * hr - aim * hi + sr[k], ti = are * hi + aim * hr + si[k]; hr = tr; hi = ti; } }
    C.out[O_RP + ((size_t)b * 32 + g) * 64 + n] = hr; C.out[O_IP + ((size_t)b * 32 + g) * 64 + n] = hi;
}
template <bool DUMMY> __device__ __forceinline__ void decode_item(const Ctx& C, int item, LAS unsigned char* ldsb) {
    typedef __attribute__((address_space(3))) const char* lcp;
    constexpr int VST = 272;
    item = __builtin_amdgcn_readfirstlane(item);
    const int sb = item / NDIT, it8 = item % NDIT, h = C.wave & 3, th = C.wave >> 2, lane = C.lane, jq = lane & 15, fq = lane >> 4, par = lane >> 5, l32 = lane & 31;
    LAS unsigned char* Vb = ldsb + C.wave * 14336;
    LAS unsigned char* Kb = Vb + 16 * VST;
    LAS unsigned char* Pb = Kb + 16 * VST;
    LAS float* Al = (LAS float*)(Pb + 1024);
    LAS bf16x8* Qs = (LAS bf16x8*)(Pb + 1024 + 64);
    for (int i = lane; i < 1024 / 4; i += 64) ((LAS unsigned*)Pb)[i] = 0u;
    if (lane < 16) Al[lane] = 1.0f;
#pragma unroll
    for (int m = 0; m < 2; ++m)
#pragma unroll
        for (int ks = 0; ks < 2; ++ks) { bf16x8 q = (bf16x8){0, 0, 0, 0, 0, 0, 0, 0}; if (jq < 4) q = *(const bf16x8*)(C.QB + (size_t)(XR0 + NMETA + sb * 4 + jq) * 512 + (h * 2 + m) * 64 + ks * 32 + fq * 8); Qs[(m * 2 + ks) * 64 + lane] = q; }
    float mrun[2] = {-INFINITY, -INFINITY}, lrun[2] = {0.f, 0.f};
    f32x4 o[8];
#pragma unroll
    for (int db = 0; db < 8; ++db) o[db] = (f32x4){0.f, 0.f, 0.f, 0.f};
    const lcp vrd = (lcp)Vb + (8 * (fq & 1) + (jq >> 2)) * VST + (jq & 3) * 8;
    const lcp krd = (lcp)Kb + jq * VST + fq * 16;
    const lcp prd = (lcp)Pb + jq * 64 + fq * 16;
    const __attribute__((address_space(4))) int* pt4 = (const __attribute__((address_space(4))) int*)(unsigned long long)C.page_table;
    f32x4 kA[8], vA[8], kB[8], vB[8];
#define DEC_ISSUE(t, KN, VN) do { const size_t page_ = (size_t)pt4[__builtin_amdgcn_readfirstlane(DUMMY ? (C.bid & 7) : sb * NPAGES + it8 * NDPG + ((t) >> 2))];     \
        const float* Kt_ = C.cache_k + (page_ * 128 + th * 64 + ((t) & 3) * 16) * 512 + h * 128; const float* Vt_ = C.cache_v + (page_ * 128 + th * 64 + ((t) & 3) * 16) * 512 + h * 128; \
        _Pragma("unroll") for (int i = 0; i < 8; ++i) KN[i] = __builtin_nontemporal_load((const f32x4*)(Kt_ + (size_t)(2 * i + par) * 512 + l32 * 4));     \
        _Pragma("unroll") for (int i = 0; i < 8; ++i) VN[i] = __builtin_nontemporal_load((const f32x4*)(Vt_ + (size_t)(2 * i + par) * 512 + l32 * 4)); } while (0)
#define DEC_CONSUME(KR, VR) do { \
        _Pragma("unroll") for (int i = 0; i < 8; ++i) { const f32x4 v = KR[i]; u32x2 w; w.x = cvt_pk_bf16(v[0], v[1]); w.y = cvt_pk_bf16(v[2], v[3]); \
            *(LAS u32x2*)(Kb + (2 * i + par) * VST + l32 * 8) = w; } \
        _Pragma("unroll") for (int i = 0; i < 8; ++i) { const f32x4 v = VR[i]; u32x2 w; w.x = cvt_pk_bf16(v[0], v[1]); w.y = cvt_pk_bf16(v[2], v[3]); \
            *(LAS u32x2*)(Vb + (2 * i + par) * VST + l32 * 8) = w; } } while (0)
#define DEC_COMPUTE() do { \
        float alpha[2]; \
        _Pragma("unroll") for (int m = 0; m < 2; ++m) { \
            f32x4 s = (f32x4){0.f, 0.f, 0.f, 0.f}; \
            s = __builtin_amdgcn_mfma_f32_16x16x32_bf16(*(const __attribute__((address_space(3))) bf16x8*)(krd + m * 128), Qs[(m * 2 + 0) * 64 + lane], s, 0, 0, 0); \
            s = __builtin_amdgcn_mfma_f32_16x16x32_bf16(*(const __attribute__((address_space(3))) bf16x8*)(krd + m * 128 + 64), Qs[(m * 2 + 1) * 64 + lane], s, 0, 0, 0); \
            float mloc = fmaxf(fmaxf(s[0], s[1]), fmaxf(s[2], s[3])); mloc = fmaxf(mloc, __shfl_xor(mloc, 16)); mloc = fmaxf(mloc, __shfl_xor(mloc, 32)); \
            const float mnew = fmaxf(mrun[m], mloc); alpha[m] = __builtin_amdgcn_exp2f(mrun[m] - mnew); mrun[m] = mnew; \
            const float p0_ = __builtin_amdgcn_exp2f(s[0] - mnew), p1_ = __builtin_amdgcn_exp2f(s[1] - mnew), p2_ = __builtin_amdgcn_exp2f(s[2] - mnew), p3_ = __builtin_amdgcn_exp2f(s[3] - mnew); \
            lrun[m] = lrun[m] * alpha[m] + ((p0_ + p1_) + (p2_ + p3_)); \
            if (jq < 4) { u32x2 w; w.x = cvt_pk_bf16(p0_, p1_); w.y = cvt_pk_bf16(p2_, p3_); *(LAS u32x2*)(Pb + (m * 4 + jq) * 64 + 8 * fq) = w; if (fq == 0) Al[m * 4 + jq] = alpha[m]; } \
        } \
        const bool resc = __any((jq < 4) && (alpha[0] != 1.0f || alpha[1] != 1.0f)); \
        asm volatile("s_waitcnt lgkmcnt(0)" ::: "memory"); \
        if (resc) { const float aq = Al[jq]; \
            _Pragma("unroll") for (int db = 0; db < 8; ++db) o[db] *= aq; } \
        { const bf16x8 pt = *(const __attribute__((address_space(3))) bf16x8*)prd; \
          _Pragma("unroll") for (int db = 0; db < 8; ++db) { const attn2::s16x4 lo = attn2::vtr(vrd + db * 32), hh = attn2::vtr(vrd + db * 32 + 4 * VST); \
              o[db] = __builtin_amdgcn_mfma_f32_16x16x32_bf16((bf16x8){lo[0], lo[1], lo[2], lo[3], hh[0], hh[1], hh[2], hh[3]}, pt, o[db], 0, 0, 0); } } \
        asm volatile("s_waitcnt lgkmcnt(0)" ::: "memory"); \
    } while (0)
    DEC_ISSUE(0, kA, vA); DEC_ISSUE(1, kB, vB);
#pragma unroll 1
    for (int t = 0; t < 4 * NDPG; t += 2) {
        DEC_CONSUME(kA, vA); if (t + 2 < 4 * NDPG) DEC_ISSUE(t + 2, kA, vA); DEC_COMPUTE();
        DEC_CONSUME(kB, vB); if (t + 3 < 4 * NDPG) DEC_ISSUE(t + 3, kB, vB); DEC_COMPUTE();
    }
#undef DEC_ISSUE
#undef DEC_CONSUME
#undef DEC_COMPUTE
#pragma unroll
    for (int m = 0; m < 2; ++m) { lrun[m] += __shfl_xor(lrun[m], 16); lrun[m] += __shfl_xor(lrun[m], 32); }
    float* base = C.DPART + (DUMMY ? (size_t)SB * NDCH * 4160 : 0) + ((((size_t)sb * NDCH + it8 * 2 + th) * 4 + h) * 8) * 130;
    if (jq < 8) {
#pragma unroll
        for (int db = 0; db < 8; ++db) { float* op = base + (size_t)jq * 130 + 2 + db * 16 + 4 * fq; *(f32x2*)op = (f32x2){o[db][0], o[db][1]}; *(f32x2*)(op + 2) = (f32x2){o[db][2], o[db][3]}; } }
#pragma unroll
    for (int m = 0; m < 2; ++m) if (jq < 4 && fq == 0) { float* op = base + (size_t)(m * 4 + jq) * 130; op[0] = mrun[m]; op[1] = lrun[m]; }
}
__device__ __forceinline__ void ocomb_finish(const Ctx& C, int row, float lam, const u32x4 a, const u32x4 b) {
    const int col = C.lane * 8; float o[8];
    o[0] = bflo(a.x) - lam * bflo(b.x); o[1] = bfhi(a.x) - lam * bfhi(b.x); o[2] = bflo(a.y) - lam * bflo(b.y); o[3] = bfhi(a.y) - lam * bfhi(b.y);
    o[4] = bflo(a.z) - lam * bflo(b.z); o[5] = bfhi(a.z) - lam * bfhi(b.z); o[6] = bflo(a.w) - lam * bflo(b.w); o[7] = bfhi(a.w) - lam * bfhi(b.w);
    float ss = 0.f;
#pragma unroll
    for (int j = 0; j < 8; ++j) ss += o[j] * o[j];
    ss += __shfl_xor(ss, 1); ss += __shfl_xor(ss, 2); ss += __shfl_xor(ss, 4); ss += __shfl_xor(ss, 8);
    const float ri = 0.8f * __builtin_amdgcn_rsqf(ss * (1.0f / 128.0f) + EPS); const float* gg = C.subln + (col & 127);
    u32x4 w; w.x = cvt_pk_bf16(o[0] * ri * gg[0], o[1] * ri * gg[1]); w.y = cvt_pk_bf16(o[2] * ri * gg[2], o[3] * ri * gg[3]); w.z = cvt_pk_bf16(o[4] * ri * gg[4], o[5] * ri * gg[5]); w.w = cvt_pk_bf16(o[6] * ri * gg[6], o[7] * ri * gg[7]);
    *(u32x4*)(C.CAT + (size_t)row * 1024 + col) = w;
}
__device__ __forceinline__ void ocomb_rows2(const Ctx& C, int r0, int r1, int rend, float lam) {
    const int col = C.lane * 8; const bool two = r1 < rend;
    const u32x4 a0 = *(const u32x4*)(C.O1 + (size_t)r0 * 512 + col), b0 = *(const u32x4*)(C.O2 + (size_t)r0 * 512 + col);
    u32x4 a1 = a0, b1 = b0; if (two) { a1 = *(const u32x4*)(C.O1 + (size_t)r1 * 512 + col); b1 = *(const u32x4*)(C.O2 + (size_t)r1 * 512 + col); }
    ocomb_finish(C, r0, lam, a0, b0); if (two) ocomb_finish(C, r1, lam, a1, b1);
}
__device__ __forceinline__ void ocomb_sample(const Ctx& C, int item, float lam) {
    const int h = item & 3, rs = item >> 2, sb = rs >> 2, si = rs & 3, lane = C.lane, row = XR0 + NMETA + rs; float o[2][2];
#pragma unroll
    for (int m = 0; m < 2; ++m) {
        const float qd = bf2f(C.QB[(size_t)row * 512 + (h * 2 + m) * 64 + lane]); float sn[4];
#pragma unroll
        for (int t = 0; t < 4; ++t) { float p = qd * C.out[O_KS + (size_t)(sb * 4 + t) * 512 + (h * 2 + m) * 64 + lane]; sn[t] = (t <= si) ? wave_sum(p) : -INFINITY; }
        float mx = fmaxf(fmaxf(sn[0], sn[1]), fmaxf(sn[2], sn[3]));
        const float* pt = C.DPART + ((((size_t)sb * NDCH) * 4 + h) * 8 + m * 4 + si) * 130;
        float pm[NDCH], pl[NDCH], pa0[NDCH], pa1[NDCH];
#pragma unroll
        for (int c = 0; c < NDCH; ++c) { pm[c] = pt[(size_t)c * 4160]; pl[c] = pt[(size_t)c * 4160 + 1]; pa0[c] = pt[(size_t)c * 4160 + 2 + 2 * lane]; pa1[c] = pt[(size_t)c * 4160 + 3 + 2 * lane]; }
#pragma unroll
        for (int c = 0; c < NDCH; ++c) mx = fmaxf(mx, pm[c]);
        float l = 0.f, a0 = 0.f, a1 = 0.f;
#pragma unroll
        for (int c = 0; c < NDCH; ++c) { const float w = exp2f(pm[c] - mx); l += w * pl[c]; a0 += w * pa0[c]; a1 += w * pa1[c]; }
#pragma unroll
        for (int t = 0; t < 4; ++t) { const float w = exp2f(sn[t] - mx); l += w; const float* vr = C.out + O_VS + (size_t)(sb * 4 + t) * 512 + h * 128 + 2 * lane; a0 += w * vr[0]; a1 += w * vr[1]; }
        o[m][0] = a0 / l; o[m][1] = a1 / l; }
    const float d0 = o[0][0] - lam * o[1][0], d1 = o[0][1] - lam * o[1][1]; const float ss = wave_sum(d0 * d0 + d1 * d1);
    const float ri = 0.8f / sqrtf(ss * (1.0f / 128.0f) + EPS);
    *(unsigned*)(C.CAT + (size_t)row * 1024 + h * 128 + 2 * lane) = pk2(d0 * ri * C.subln[2 * lane], d1 * ri * C.subln[2 * lane + 1]);
}
__device__ __forceinline__ f32x4 h1_at(const Ctx& C, int row, int back, int col, const f32x4 g) {
    int rr;
    if (row < NMAIN) { const int b = row >> 13, i = row & (SEQ - 1), pp = NMETA + i - back; rr = pp >= NMETA ? b * SEQ + pp - NMETA : XR0 + pp; }
    else { const int rs = row - XR0 - NMETA, sb = rs >> 2, si = rs & 3, idx = 15 + si - back; if (idx < 15) return *(const f32x4*)(C.st_pool + ((size_t)sb * 15 + idx) * 1024 + col); rr = XR0 + NMETA + sb * 4 + idx - 15; }
    const float rinv = 1.0f / sqrtf(C.rowsq[(size_t)2 * RG + rr] * (1.0f / 1024.0f) + EPS);
    const u32x2 x = *(const u32x2*)(C.XB + (size_t)rr * 1024 + col); return (f32x4){bflo(x.x), bfhi(x.x), bflo(x.y), bfhi(x.y)} * rinv * g;
}
__device__ __forceinline__ void pool_row_g(const Ctx& C, int row, int gi) {
    const bool valid = (row >= XR0 + NMETA && row < RVALID);
    const int col = gi * 256 + C.lane * 4, win = 2 << gi; u32x2* dst = (u32x2*)(C.PA + (size_t)row * 1024 + col);
    if (!valid) { *dst = (u32x2){0u, 0u}; return; }
    const f32x4 g = *(const f32x4*)(C.norm_mix + 1024 + col); const f32x4 cur = h1_at(C, row, 0, col, g); f32x4 s = cur;
#pragma unroll
    for (int j = 1; j < 16; ++j) if (j < win) s += h1_at(C, row, j, col, g);
    const f32x4 q = s * (1.0f / (float)win) - cur; *dst = (u32x2){pk2(q.x, q.y), pk2(q.z, q.w)};
    const int rs = row - XR0 - NMETA, sb = rs >> 2, si = rs & 3; *(f32x4*)(C.out + O_PS + ((size_t)sb * 15 + 11 + si) * 1024 + col) = cur;
    if (si == 0) for (int j = 0; j < 11; ++j) *(f32x4*)(C.out + O_PS + ((size_t)sb * 15 + j) * 1024 + col) = *(const f32x4*)(C.st_pool + ((size_t)sb * 15 + 4 + j) * 1024 + col);
}
__device__ __forceinline__ f32x4 pool_y(const Ctx& C, int b, int p, int col, const f32x4 g) {
    const int rr = p >= NMETA ? b * SEQ + p - NMETA : XR0 + p;
    const float rinv = __builtin_amdgcn_rsqf(C.rowsq[(size_t)2 * RG + rr] * (1.0f / 1024.0f) + EPS);
    const u32x2 x = *(const u32x2*)(C.XB + (size_t)rr * 1024 + col); return (f32x4){bflo(x.x), bfhi(x.x), bflo(x.y), bfhi(x.y)} * rinv * g;
}
__device__ __forceinline__ void pool_strip(const Ctx& C, int item) {
    const int gi = item & 3, strip = (item >> 2) & 255, b = item >> 10, win = 2 << gi, col = gi * 256 + C.lane * 4, p0 = NMETA + strip * 32;
    const f32x4 g = *(const f32x4*)(C.norm_mix + 1024 + col); const float iw = 1.0f / (float)win;
    f32x4 s = (f32x4){0.f, 0.f, 0.f, 0.f};
#pragma unroll
    for (int j = 1; j < 16; ++j) if (j < win) s += pool_y(C, b, p0 - j, col, g);
#pragma unroll 1
    for (int t0 = 0; t0 < 32; t0 += 8) {
        f32x4 y[8], yo[8];
#pragma unroll
        for (int k = 0; k < 8; ++k) { y[k] = pool_y(C, b, p0 + t0 + k, col, g); yo[k] = pool_y(C, b, p0 + t0 + k - win + 1, col, g); }
#pragma unroll
        for (int k = 0; k < 8; ++k) { const int p = p0 + t0 + k; s += y[k]; const f32x4 q = s * iw - y[k]; const int row = b * SEQ + p - NMETA;
            *(u32x2*)(C.PA + (size_t)row * 1024 + col) = (u32x2){pk2(q.x, q.y), pk2(q.z, q.w)}; s -= yo[k];
            const int i = p - NMETA; if (i >= SEQ - 15) *(f32x4*)(C.out + O_PP + ((size_t)b * 15 + (i - (SEQ - 15))) * 1024 + col) = y[k]; }
    }
}
__device__ __forceinline__ void final_row(const Ctx& C, int row) {
    float* o = row < NMAIN ? C.out + O_YP + (size_t)row * 1024 : C.out + O_YS + (size_t)(row - XR0 - NMETA) * 1024;
    const float rinv = __builtin_amdgcn_rsqf(C.rowsq[(size_t)4 * RG + row] * (1.0f / 1024.0f) + EPS);
    const u32x4* xp = (const u32x4*)(C.XB2 + (size_t)row * 1024) + C.lane;
#pragma unroll
    for (int j = 0; j < 2; ++j) { const u32x4 x = xp[64 * j]; const f32x4 g0 = *((const f32x4*)C.norm_final + 128 * j + 2 * C.lane), g1 = *((const f32x4*)C.norm_final + 128 * j + 2 * C.lane + 1);
        *((f32x4*)o + 128 * j + 2 * C.lane) = (f32x4){bflo(x.x), bfhi(x.x), bflo(x.y), bfhi(x.y)} * rinv * g0; *((f32x4*)o + 128 * j + 2 * C.lane + 1) = (f32x4){bflo(x.z), bfhi(x.z), bflo(x.w), bfhi(x.w)} * rinv * g1; }
}
__device__ __forceinline__ void final_rows4(const Ctx& C, int r, int stride) {
    u32x4 x[4][2]; float ri[4];
#pragma unroll
    for (int q = 0; q < 4; ++q) { const int row = r + q * stride; if (row < NMAIN) { const u32x4* xp = (const u32x4*)(C.XB2 + (size_t)row * 1024) + C.lane; x[q][0] = xp[0]; x[q][1] = xp[64];
            ri[q] = __builtin_amdgcn_rsqf(C.rowsq[(size_t)4 * RG + row] * (1.0f / 1024.0f) + EPS); } }
#pragma unroll
    for (int q = 0; q < 4; ++q) { const int row = r + q * stride; if (row < NMAIN) { float* o = C.out + O_YP + (size_t)row * 1024;
#pragma unroll
            for (int j = 0; j < 2; ++j) { const u32x4 v = x[q][j]; const f32x4 g0 = *((const f32x4*)C.norm_final + 128 * j + 2 * C.lane), g1 = *((const f32x4*)C.norm_final + 128 * j + 2 * C.lane + 1);
                *((f32x4*)o + 128 * j + 2 * C.lane) = (f32x4){bflo(v.x), bfhi(v.x), bflo(v.y), bfhi(v.y)} * ri[q] * g0; *((f32x4*)o + 128 * j + 2 * C.lane + 1) = (f32x4){bflo(v.z), bfhi(v.z), bflo(v.w), bfhi(v.w)} * ri[q] * g1; } } }
}
}

#ifndef MK_P3_MULT
#define MK_P3_MULT 1
#endif
#ifndef MK_NDEC
#define MK_NDEC 96
#endif
#ifndef MK_P4_PARTS
#define MK_P4_PARTS 3
#endif
namespace mk {
constexpr int NPH = 14;
struct EpiNull { Ctx C; __device__ __forceinline__ void operator()(const pg8::f32x4 (&acc)[2][2][4][2], const pg8::Unit& u, int wr, int wc, int fr, int fq) const { pg8::f32x4 s = acc[0][0][0][0]; _Pragma("unroll") for (int a = 0; a < 2; ++a) _Pragma("unroll") for (int b = 0; b < 2; ++b) _Pragma("unroll") for (int m = 0; m < 4; ++m) _Pragma("unroll") for (int n = 0; n < 2; ++n) s += acc[a][b][m][n]; if (s[0] + s[1] + s[2] + s[3] == 1.2345e30f) C.rowsq[0] = 1.f; } };
#ifndef MK_ONE_LAUNCH
#define MK_ONE_LAUNCH 1
#endif
__global__ void __launch_bounds__(NTHR, 2) mega_fwd(Args args) {
    extern __shared__ __attribute__((aligned(16))) unsigned char lds[];
    Ctx C; ctx_init(C, args, (LAS unsigned char*)lds);
    for (int u = C.tid; u < (LDS_BYTES - LDSCTL_OFF) / 4; u += NTHR) ((LAS unsigned*)(C.lds + LDSCTL_OFF))[u] = 0u;
    __syncthreads();
    XcdBarrier bar = xcd_barrier_post(C.ctl + CW_BAR, C.MISC + 8);
    const int lo = args.ph_lo, hi = args.ph_hi;
#ifndef MK_PHASE_MASK
#define MK_PHASE_MASK 0x3fff
#endif
#define IN(k) (((MK_PHASE_MASK >> (k)) & 1) && lo <= (k) && (k) < hi)
#define SEAM(k) do { if (IN(k) && IN((k) + 1)) xcd_barrier(bar); } while (0)
#ifndef MK_REPEAT_MASK
#define MK_REPEAT_MASK 0
#endif
#define NREP(k) ((((MK_REPEAT_MASK) >> (k)) & 1) + 1)
#define REPBAR(k) do { if (NREP(k) > 1 && rep + 1 < NREP(k)) xcd_barrier(bar); } while (0)
    const int gw = C.bid * NWAVES + C.wave, NGW = C.G * NWAVES;
    LAS unsigned char* ring = C.lds + RING_OFF;

    if (IN(0)) _Pragma("unroll") for (int rep = 0; rep < NREP(0); ++rep) { p0_prologue(C);  REPBAR(0); } SEAM(0);

    if (IN(1)) _Pragma("unroll") for (int rep = 0; rep < NREP(1); ++rep) {
        EpiProj SE{C}; xgemm<5, 64>(C, C.XB, 1024, C.WIN, 1024, 2048, 1024, 0, SE, ring); __syncthreads();
        pg8::Gemm g{C.XB, C.WIN, 1024, 1024, 1024, 0, 0, 0}; pg8::Order S; S.init(NTILE, 8, 1, C.G, C.bid);
        EpiTile<EpiProj> E{SE};
#if defined(MK_PROBE_F1)
        { pg8::gemm_phase(ring, g, S, E); xcd_barrier(bar); }
#endif
        pg8::gemm_phase(ring, g, S, E);
     REPBAR(1); } SEAM(1);

    if (IN(2)) _Pragma("unroll") for (int rep = 0; rep < NREP(2); ++rep) {
        { pg8::Gemm g{C.A2, C.S5A, 256, 384, 256, 0, (long)1024 * 384, (long)256 * 256}; pg8::Order S; S.init(4, 1, 32, C.G, C.bid); EpiS5a E{C}; pg8::gemm_phase(ring, g, S, E); }
        const int xb0 = C.G > 128 ? 128 : 0;
        { const int nfree = (C.G - xb0) * NWAVES, total = 32 + 128 + 1024;
          for (int w = (C.bid >= xb0 ? (C.bid - xb0) * NWAVES + C.wave : nfree + C.bid * NWAVES + C.wave); w < total; w += C.G * NWAVES) {
              if (w < 32) s5x_item(C, w); else if (w < 160) meta_attn_item(C, w - 32); else s5x_item(C, 32 + (w - 160)); } }
     REPBAR(2); } SEAM(2);

    if (IN(3)) _Pragma("unroll") for (int rep = 0; rep < NREP(3); ++rep) {
        for (int it = gw; it < 64; it += NGW) s5_scan_item(C, it);
        asm volatile("s_waitcnt vmcnt(0)" ::: "memory"); __syncthreads();
        if (C.tid == 0) { if (C.bid * NWAVES < 64) { __builtin_amdgcn_fence(__ATOMIC_RELEASE, "agent"); asm volatile("s_waitcnt vmcnt(0)" ::: "memory"); } __hip_atomic_fetch_add(C.ctl + CW_QUEUE + 448, 1u, RLX_AGENT); }
#ifndef MK_P3_PARTS
#define MK_P3_PARTS 3
#endif
        if ((MK_P3_PARTS & 1) && C.bid < (C.G >= 256 ? MK_NDEC : C.G)) for (;;) {
            if (C.tid == 0) C.MISC[16] = __hip_atomic_fetch_add(C.ctl + CW_QUEUE + 128 * rep, 1u, RLX_AGENT);
            __syncthreads();
            const int idx = (int)C.MISC[16];
            __syncthreads();
            if (idx >= SB * NDIT * MK_P3_MULT) break;
            decode_item<false>(C, idx % (SB * NDIT), ring);
        }
#if defined(MK_DEC_DUMMY)
        if (C.bid < (C.G >= 256 ? MK_NDEC : C.G)) for (;;) {
            if (C.tid == 0) C.MISC[16] = __hip_atomic_fetch_add(C.ctl + CW_QUEUE + 256, 1u, RLX_AGENT);
            __syncthreads();
            const int idx = (int)C.MISC[16];
            __syncthreads();
            if (idx >= 256) break;
            decode_item<true>(C, idx, ring);
        }
#endif
        if (MK_P3_PARTS & 2) for (;;) {
#if defined(MK_XCD_QUEUES)
            const int xq = C.bid & 7;
            if (C.tid == 0) C.MISC[16] = __hip_atomic_fetch_add(C.ctl + CW_QUEUE + 512 + 64 * xq + 1024 * rep, 1u, RLX_AGENT);
            __syncthreads();
            const int a = (int)C.MISC[16];
            __syncthreads();
            if (a >= 64 * MK_P3_MULT) break;
            const int qb = 31 - ((a & 63) >> 1), st = 2 * xq + (a & 1), b = st >> 3, hq = st & 7;
#else
            if (C.tid == 0) C.MISC[16] = __hip_atomic_fetch_add(C.ctl + CW_QUEUE + 64 + 128 * rep, 1u, RLX_AGENT);
            __syncthreads();
            const int a = (int)C.MISC[16];
            __syncthreads();
            if (a >= 512 * MK_P3_MULT) break;
            const int qb = 31 - ((a & 511) >> 4), b = (a >> 3) & 1, hq = a & 7;
#endif
            attn2::attn_unit<8>(b, hq, qb, (const attn2::bf16*)C.QB, (const attn2::bf16*)C.KB, (const attn2::bf16*)C.VB, (attn2::bf16*)C.O1, (attn2::bf16*)C.O2, (char*)lds + RING_OFF);
        }
        { bool acq = false;
          for (;;) {
            if (C.tid == 0) C.MISC[16] = __hip_atomic_fetch_add(C.ctl + CW_QUEUE + 384, 1u, RLX_AGENT);
            __syncthreads();
            const int idx = (int)C.MISC[16];
            __syncthreads();
            if (idx >= 128) break;
            if (!acq) { acq = true;
                if (C.wave == 0) { unsigned sp = 0; while (__hip_atomic_load(C.ctl + CW_QUEUE + 448, RLX_AGENT) < (unsigned)C.G && ++sp < (1u << 22)) __builtin_amdgcn_s_sleep(2);
                    __builtin_amdgcn_fence(__ATOMIC_ACQUIRE, "agent"); }
                asm volatile("s_waitcnt vmcnt(0)" ::: "memory"); __syncthreads(); }
            pg8::Gemm g{C.A2, C.S5C, 384, 384, 384, 0, (long)1024 * 384, (long)256 * 384}; pg8::Order S; S.init(4, 1, 32, 128, idx); EpiS5c E{C}; pg8::gemm_phase(ring, g, S, E);
          } }
        for (;;) {
            if (C.tid == 0) C.MISC[16] = __hip_atomic_fetch_add(C.ctl + CW_QUEUE + 320, 1u, RLX_AGENT);
            __syncthreads();
            const int base = (int)C.MISC[16] * NWAVES;
            __syncthreads();
            if (base >= N_LATE) break;
            if (base + C.wave < N_LATE) late_weight_item(C, base + C.wave, (LAS float*)(ring + C.wave * 16384));
        }
     REPBAR(3); } SEAM(3);

    if (IN(4)) _Pragma("unroll") for (int rep = 0; rep < NREP(4); ++rep) {
        const int xb0 = C.G > 128 ? 128 : 0;
        const float lam = lam_full(C);
        if (xb0 == 0 || C.bid < xb0) { const int w0 = gw, nw = (xb0 ? xb0 : C.G) * NWAVES;
            for (int r = w0; r < XR0 + NMETA; r += 2 * nw) ocomb_rows2(C, r, r + nw, XR0 + NMETA, lam);
            for (int it = w0; it < NSAMP * 4; it += nw) ocomb_sample(C, it, lam); }
        __syncthreads();
        { EpiGlu SE{C}; xgemm<2, 64>(C, C.YS, 512, C.WGLU, 512, 512, 512, 0, SE, ring); __syncthreads();
          pg8::Gemm g{C.YS, C.WGLU, 512, 512, 512, 0, 0, 0}; pg8::Order S; const int ng = C.G - xb0;
          if (C.bid >= xb0) { S.init(NTILE, 2, 1, ng, C.bid - xb0); EpiTile<EpiGlu> E{SE}; pg8::gemm_phase(ring, g, S, E); } }
     REPBAR(4); } SEAM(4);

    if (IN(6)) _Pragma("unroll") for (int rep = 0; rep < NREP(6); ++rep) {
        EpiResid<0> SE{C, 1, C.XB, C.XB}; xgemm<2, 64>(C, C.CAT, 1024, C.WO, 1024, 1024, 1024, 0, SE, ring); __syncthreads();
        pg8::Gemm g{C.CAT, C.WO, 1024, 1024, 1024, 0, 0, 0}; pg8::Order S; S.init(NTILE, 4, 1, C.G, C.bid); EpiTile<EpiResid<0>> E{SE};
#if defined(MK_PROBE_F6)
        { EpiResid<0> SD{C, 7, C.PA, C.XB}; xgemm<2, 64>(C, C.CAT, 1024, C.WO, 1024, 1024, 1024, 0, SD, ring); __syncthreads(); EpiTile<EpiResid<0>> ED{SD}; pg8::gemm_phase(ring, g, S, ED); xcd_barrier(bar); }
#endif
        pg8::gemm_phase(ring, g, S, E);
     REPBAR(6); } SEAM(6);

    if (IN(7)) _Pragma("unroll") for (int rep = 0; rep < NREP(7); ++rep) { EpiUp SE{C, 1};
#if defined(MK_PROBE_X7)
        xgemm<5, 64>(C, C.XB, 1024, C.WUP0, 1024, 4096, 1024, 0, SE, ring); __syncthreads(); xgemm<5, 64>(C, C.XB, 1024, C.WUP0, 1024, 4096, 1024, 0, SE, ring); __syncthreads(); xgemm<5, 64>(C, C.XB, 1024, C.WUP0, 1024, 4096, 1024, 0, SE, ring); __syncthreads();
#endif
        xgemm<5, 64>(C, C.XB, 1024, C.WUP0, 1024, 4096, 1024, 0, SE, ring); __syncthreads();
        pg8::Gemm g{C.XB, C.WUP0, 1024, 1024, 1024, 0, 0, 0}; pg8::Order S; S.init(NTILE, 16, 1, C.G, C.bid); EpiTile<EpiUp> E{SE};
#if defined(MK_PROBE_NOEPI)
        if (rep == 1) { EpiNull EN{C}; pg8::gemm_phase(ring, g, S, EN); } else
#endif
        pg8::gemm_phase(ring, g, S, E);  REPBAR(7); } SEAM(7);
    if (IN(8)) _Pragma("unroll") for (int rep = 0; rep < NREP(8); ++rep) { EpiResid<1> SE{C, 2, C.XB, C.XB}; xgemm<2, 64>(C, C.HB, 4096, C.WDN0, 4096, 1024, 4096, 0, SE, ring); __syncthreads();
        pg8::Gemm g{C.HB, C.WDN0, 4096, 4096, 4096, 0, 0, 0}; pg8::Order S; S.init(NTILE, 4, 1, C.G, C.bid); EpiTile<EpiResid<1>> E{SE};
#if defined(MK_PROBE_K8)
        { EpiNull EN{C}; pg8::gemm_phase(ring, g, S, EN); __syncthreads(); }
#endif
#if defined(MK_PROBE_F8)
        { EpiResid<1> SD{C, 7, C.PA, C.XB}; xgemm<2, 64>(C, C.HB, 4096, C.WDN0, 4096, 1024, 4096, 0, SD, ring); __syncthreads(); EpiTile<EpiResid<1>> ED{SD}; pg8::gemm_phase(ring, g, S, ED); xcd_barrier(bar); }
#endif
        pg8::gemm_phase(ring, g, S, E);  REPBAR(8); } SEAM(8);

    if (IN(10)) _Pragma("unroll") for (int rep = 0; rep < NREP(10); ++rep) {
        EpiResid<2> SE{C, 3, C.XB2, C.XB};
#if defined(MK_PROBE_P10A)
        for (int u = C.bid; u < 32 * 5; u += C.G) { const int cg = u & 31, rc = u >> 5; for (int rr = C.wave; rr < 32; rr += NWAVES) pool_row_g(C, XR0 + rc * 32 + rr, cg >> 3); }
        xcd_barrier(bar);
#endif
        for (int u = C.bid; u < 32 * 5; u += C.G) { const int cg = u & 31, rc = u >> 5; for (int rr = C.wave; rr < 32; rr += NWAVES) pool_row_g(C, XR0 + rc * 32 + rr, cg >> 3); }
        asm volatile("s_waitcnt vmcnt(0)" ::: "memory"); __syncthreads();
        xgemm<2, 32>(C, C.PA, 1024, C.POOLT, 256, 1024, 256, 256, SE, ring); __syncthreads();
        pg8::Gemm g{C.PA, C.POOLT, 256, 1024, 256, 256, 0, 0}; pg8::Order S; S.init(NTILE, 4, 1, C.G, C.bid);
#if defined(MK_PROBE_P10B)
        { pg8::Unit u; for (int i = 0; S.next(i, u); ++i) pool_strip(C, ((u.pm >> 5) << 10) | ((((u.pm & 31) << 3) | C.wave) << 2) | u.pn); }
        xcd_barrier(bar);
#endif
        { pg8::Unit u; for (int i = 0; S.next(i, u); ++i) pool_strip(C, ((u.pm >> 5) << 10) | ((((u.pm & 31) << 3) | C.wave) << 2) | u.pn); }
        asm volatile("s_waitcnt vmcnt(0)" ::: "memory"); __syncthreads();
        EpiTile<EpiResid<2>> E{SE}; pg8::gemm_phase(ring, g, S, E);
         REPBAR(10); } SEAM(10);

    if (IN(11)) _Pragma("unroll") for (int rep = 0; rep < NREP(11); ++rep) { EpiUp SE{C, 3}; xgemm<5, 64>(C, C.XB2, 1024, C.WUP1, 1024, 4096, 1024, 0, SE, ring); __syncthreads();
        pg8::Gemm g{C.XB2, C.WUP1, 1024, 1024, 1024, 0, 0, 0}; pg8::Order S; S.init(NTILE, 16, 1, C.G, C.bid); EpiTile<EpiUp> E{SE}; pg8::gemm_phase(ring, g, S, E);  REPBAR(11); } SEAM(11);
    if (IN(12)) { EpiResid<3> SE{C, 4, C.XB2, C.XB2}; xgemm<2, 64>(C, C.HB, 4096, C.WDN1, 4096, 1024, 4096, 0, SE, ring);
        asm volatile("s_waitcnt vmcnt(0)" ::: "memory"); __syncthreads();
        if (C.tid == 0) { if (C.bid < 160) { __builtin_amdgcn_fence(__ATOMIC_RELEASE, "agent"); asm volatile("s_waitcnt vmcnt(0)" ::: "memory"); } __hip_atomic_fetch_add(C.ctl + CW_FINX, 1u, RLX_AGENT); }
        pg8::Gemm g{C.HB, C.WDN1, 4096, 4096, 4096, 0, 0, 0}; pg8::Order S; S.init(NTILE, 4, 1, C.G, C.bid); EpiFinal E{C, C.ctl + CW_FIN}; pg8::gemm_phase(ring, g, S, E);
        if (XR0 + NMETA + C.bid * NWAVES < RVALID) {
            if (C.wave == 0) { unsigned sp = 0; while (__hip_atomic_load(C.ctl + CW_FINX, RLX_AGENT) < (unsigned)C.G && ++sp < (1u << 22)) __builtin_amdgcn_s_sleep(2);
                __builtin_amdgcn_fence(__ATOMIC_ACQUIRE, "agent"); }
            asm volatile("s_waitcnt vmcnt(0)" ::: "memory"); __syncthreads();
            for (int r = XR0 + NMETA + gw; r < RVALID; r += NGW) final_row(C, r); } }
#undef IN
#undef SEAM
}
}

#ifndef MK_CHECK
#define MK_CHECK 0
#endif
extern "C" void kernel_launch(void* const* d_in, const int* in_sizes, int n_in, void* d_out, int out_size, void* d_ws, size_t ws_size, hipStream_t stream) {
    using namespace mk;
    static int grid = 0;
    if (grid == 0) {
        if (n_in != 34 || (size_t)out_size != O_END || ws_size < WS_END) { fprintf(stderr, "kernel_launch: unexpected sizes n_in %d out %d ws %zu\n", n_in, out_size, ws_size); grid = -1; return; }
        int dev = 0, cus = 0, per_cu = 0;
        if (hipGetDevice(&dev) != hipSuccess || hipDeviceGetAttribute(&cus, hipDeviceAttributeMultiprocessorCount, dev) != hipSuccess) { grid = -1; return; }
        if (hipFuncSetAttribute((const void*)mega_fwd, hipFuncAttributeMaxDynamicSharedMemorySize, LDS_BYTES) != hipSuccess) { fprintf(stderr, "kernel_launch: hipFuncSetAttribute failed\n"); grid = -1; return; }
        if (hipOccupancyMaxActiveBlocksPerMultiprocessor(&per_cu, (const void*)mega_fwd, NTHR, LDS_BYTES) != hipSuccess || per_cu < 1) fprintf(stderr, "kernel_launch: occupancy query says %d\n", per_cu);
        (void)hipGetLastError();
        grid = cus;
    }
    if (grid < 0) return;
    (void)hipMemsetAsync((char*)d_ws + WS_CTL, 0, CTL_ZERO_BYTES, stream);
    Args a{};
    for (int i = 0; i < 34; ++i) a.in[i] = (const float*)d_in[i];
    a.out = (float*)d_out; a.ws = (unsigned char*)d_ws;
#if MK_CHECK
    check_run(a, d_in, (float*)d_out, (unsigned char*)d_ws, ws_size, grid, stream);
#else
#if MK_ONE_LAUNCH
    a.ph_lo = 0; a.ph_hi = NPH;
    hipLaunchKernelGGL(mega_fwd, dim3(grid), dim3(NTHR), LDS_BYTES, stream, a);
#else
    for (int k = 0; k < NPH; ++k) { a.ph_lo = k; a.ph_hi = k + 1; hipLaunchKernelGGL(mega_fwd, dim3(grid), dim3(NTHR), LDS_BYTES, stream, a); }
#endif
#endif
}
```
